# Optimizing an MI355X kernel written in HIP

```python
import math
import jax, jax.numpy as jnp
from jax import lax
import numpy as np

D_MODEL = 1024
BATCH = 8
SEQ = 2048
DEPTH = 2

N_MEM = 256
GRID_W = 64
HY_W = 512
NA_HEADS = 8
NA_HEAD_DIM = 64
NA_W = NA_HEADS * NA_HEAD_DIM
NA_WIN_ROWS = 8
NA_WIN_COLS = 16
SC_W = 512
XA_HEADS = 4
XA_HEAD_DIM = D_MODEL // XA_HEADS
D_FF = 2816
HY_ORDER = 2
HY_EMB = 33
HY_HIDDEN = 64
HY_FAST_DECAY = 0.3
HY_SLOW_DECAY = 1.5
HY_TARGET = 1e-2
N_BRANCH = 3
EPS = 1e-6
PROJ_W = 3 * HY_W + 3 * NA_W + 3 * SC_W + N_BRANCH * D_MODEL

kernel_name = "hybrid_hyena_natten_shortconv_encoder"


def rms_norm(x, g):
    xf = x.astype(jnp.float32)
    y = xf * lax.rsqrt(jnp.mean(xf * xf, axis=-1, keepdims=True) + EPS)
    return (y * g.astype(jnp.float32)).astype(x.dtype)


def dwconv3(x, w):
    xp = jnp.pad(x, ((0, 0), (1, 1), (0, 0)))
    return xp[:, :-2] * w[0] + xp[:, 1:-1] * w[1] + xp[:, 2:] * w[2]


def hyena_filters(L, w1, b1, w2, b2, w3, freq):
    f32 = jnp.float32
    t = jnp.linspace(0.0, 1.0, L, dtype=f32)[:, None]
    bands = (HY_EMB - 1) // 2
    w = 2.0 * math.pi * jnp.arange(L, dtype=f32)[:, None] / L
    f = jnp.linspace(1e-4, bands - 1, bands, dtype=f32)[None, :]
    z = jnp.concatenate([t, jnp.cos(f * w), -jnp.sin(f * w)], axis=-1)
    h = jnp.sin(freq[0].astype(f32) * (z @ w1.astype(f32) + b1.astype(f32)))
    h = jnp.sin(freq[1].astype(f32) * (h @ w2.astype(f32) + b2.astype(f32)))
    h = (h @ w3.astype(f32)).reshape(L, 2, HY_ORDER, HY_W)
    deltas = jnp.abs(jnp.linspace(math.log(HY_TARGET) / HY_SLOW_DECAY,
                                  math.log(HY_TARGET) / HY_FAST_DECAY, HY_W, dtype=f32))
    h = h * jnp.exp(-t * deltas)[:, None, None, :]
    h_fwd, h_bwd = h[:, 0], h[:, 1]
    k2 = jnp.concatenate([h_fwd, jnp.zeros((1, HY_ORDER, HY_W), f32), h_bwd[1:][::-1]], axis=0)
    return jnp.fft.rfft(k2, axis=0)


def long_conv(z, kf, bias):
    L = z.shape[1]
    zf32 = z.astype(jnp.float32)
    zf = jnp.fft.rfft(zf32, n=2 * L, axis=1)
    y = jnp.fft.irfft(zf * kf[None], n=2 * L, axis=1)[:, :L]
    return (y + zf32 * bias.astype(jnp.float32)).astype(z.dtype)


def hyena_mixer(u, short_w, kf, bias):
    u = dwconv3(u, short_w)
    v, x1, x2 = jnp.split(u, 3, axis=-1)
    z = x1 * long_conv(v, kf[:, 0], bias[0])
    return x2 * long_conv(z, kf[:, 1], bias[1])


def neighbourhood_attention(q, k, v, rpb):
    B, L, _ = q.shape
    rows = L // GRID_W
    kr = min(NA_WIN_ROWS, rows)

    def grid(t):
        return t.reshape(B, rows, GRID_W, NA_HEADS, NA_HEAD_DIM).transpose(0, 3, 1, 2, 4)

    qg = grid(q) * (NA_HEAD_DIM ** -0.5)
    kg, vg = grid(k), grid(v)
    r = jnp.arange(rows)
    row_idx = jnp.clip(r - kr // 2, 0, rows - kr)[:, None] + jnp.arange(kr)[None, :]
    k_rows = kg[:, :, row_idx]
    v_rows = vg[:, :, row_idx]
    c = jnp.arange(GRID_W)
    col_start = jnp.clip(c - NA_WIN_COLS // 2, 0, GRID_W - NA_WIN_COLS)
    col_mask = (c[None, :] >= col_start[:, None]) & (c[None, :] < col_start[:, None] + NA_WIN_COLS)
    dr = row_idx - r[:, None] + (NA_WIN_ROWS - 1)
    dc = jnp.clip(c[None, :] - c[:, None] + NA_WIN_COLS - 1, 0, 2 * NA_WIN_COLS - 2)
    bias = rpb[:, dr][..., dc].transpose(0, 1, 3, 2, 4)
    s = jnp.einsum('bhrqd,bhrkcd->bhrqkc', qg, k_rows).astype(jnp.float32)
    s = s + bias[None].astype(jnp.float32)
    s = jnp.where(col_mask[:, None, :], s, -1e30)
    p = jax.nn.softmax(s, axis=(-2, -1)).astype(v.dtype)
    o = jnp.einsum('bhrqkc,bhrkcd->bhrqd', p, v_rows)
    return o.transpose(0, 2, 3, 1, 4).reshape(B, L, NA_W)


def short_conv_mixer(b_gate, c_gate, x_in, w):
    return b_gate * dwconv3(c_gate * x_in, w)


def memory_cross_attention(h, mem_n, wq, wkv, wo):
    B, L, _ = h.shape
    M = mem_n.shape[1]
    q = (h @ wq).reshape(B, L, XA_HEADS, XA_HEAD_DIM)
    km, vm = jnp.split(mem_n @ wkv, 2, axis=-1)
    km = km.reshape(B, M, XA_HEADS, XA_HEAD_DIM)
    vm = vm.reshape(B, M, XA_HEADS, XA_HEAD_DIM)
    s = jnp.einsum('bshd,bmhd->bhsm', q, km).astype(jnp.float32) * (XA_HEAD_DIM ** -0.5)
    p = jax.nn.softmax(s, axis=-1).astype(h.dtype)
    o = jnp.einsum('bhsm,bmhd->bshd', p, vm).reshape(B, L, D_MODEL)
    return o @ wo


def conv_glu_ffn(h, w_up, w_conv, w_down):
    u = dwconv3(h @ w_up, w_conv)
    g, val = jnp.split(u, 2, axis=-1)
    return (jax.nn.gelu(g, approximate=True) * val) @ w_down


def setup_inputs(seed: int = 0) -> dict:
    key = jax.random.key(seed)
    ks = jax.random.split(key, 24)

    def nrm(k, shape, scale):
        return jax.random.normal(k, shape, jnp.float32) * scale

    return {
        "x": nrm(ks[0], (BATCH, SEQ, D_MODEL), 1.0),
        "mem": nrm(ks[1], (BATCH, N_MEM, D_MODEL), 1.0),
        "norm_gains": 1.0 + nrm(ks[2], (DEPTH, 6, D_MODEL), 0.05),
        "mem_norm": 1.0 + nrm(ks[3], (DEPTH, D_MODEL), 0.05),
        "w_in": nrm(ks[4], (DEPTH, D_MODEL, PROJ_W), D_MODEL ** -0.5),
        "gate_bias": nrm(ks[5], (DEPTH, N_BRANCH, D_MODEL), 0.02),
        "hy_short_w": nrm(ks[6], (DEPTH, 3, 3 * HY_W), 3 ** -0.5),
        "hy_w1": nrm(ks[7], (DEPTH, HY_EMB, HY_HIDDEN), HY_EMB ** -0.5),
        "hy_b1": nrm(ks[8], (DEPTH, HY_HIDDEN), 0.02),
        "hy_w2": nrm(ks[9], (DEPTH, HY_HIDDEN, HY_HIDDEN), HY_HIDDEN ** -0.5),
        "hy_b2": nrm(ks[10], (DEPTH, HY_HIDDEN), 0.02),
        "hy_w3": nrm(ks[11], (DEPTH, HY_HIDDEN, 2 * HY_ORDER * HY_W), 0.05 * HY_HIDDEN ** -0.5),
        "hy_freq": 1.0 + nrm(ks[12], (DEPTH, 2, HY_HIDDEN), 0.05),
        "hy_bias": nrm(ks[13], (DEPTH, HY_ORDER, HY_W), 0.1),
        "na_rpb": nrm(ks[14], (DEPTH, NA_HEADS, 2 * NA_WIN_ROWS - 1, 2 * NA_WIN_COLS - 1), 0.02),
        "sc_conv_w": nrm(ks[15], (DEPTH, 3, SC_W), 3 ** -0.5),
        "w_branch": nrm(ks[16], (DEPTH, N_BRANCH, HY_W, D_MODEL), HY_W ** -0.5),
        "w_out": nrm(ks[17], (DEPTH, D_MODEL, D_MODEL), D_MODEL ** -0.5),
        "xa_wq": nrm(ks[18], (DEPTH, D_MODEL, D_MODEL), D_MODEL ** -0.5),
        "xa_wkv": nrm(ks[19], (DEPTH, D_MODEL, 2 * D_MODEL), D_MODEL ** -0.5),
        "xa_wo": nrm(ks[20], (DEPTH, D_MODEL, D_MODEL), D_MODEL ** -0.5),
        "ffn_up": nrm(ks[21], (DEPTH, D_MODEL, 2 * D_FF), D_MODEL ** -0.5),
        "ffn_conv": nrm(ks[22], (DEPTH, 3, 2 * D_FF), 3 ** -0.5),
        "ffn_down": nrm(ks[23], (DEPTH, D_FF, D_MODEL), D_FF ** -0.5),
    }


def reference(x, mem, norm_gains, mem_norm, w_in, gate_bias, hy_short_w, hy_w1, hy_b1, hy_w2, hy_b2,
              hy_w3, hy_freq, hy_bias, na_rpb, sc_conv_w, w_branch, w_out, xa_wq, xa_wkv, xa_wo,
              ffn_up, ffn_conv, ffn_down):
    B, L, _ = x.shape
    splits = [3 * HY_W, 3 * HY_W + 3 * NA_W, 3 * HY_W + 3 * NA_W + 3 * SC_W]
    for l in range(DEPTH):
        g = norm_gains[l]
        h = rms_norm(x, g[0])
        proj = h @ w_in[l]
        hy_u, na_qkv, sc_u, gate_pre = jnp.split(proj, splits, axis=-1)
        kf = hyena_filters(L, hy_w1[l], hy_b1[l], hy_w2[l], hy_b2[l], hy_w3[l], hy_freq[l])
        y_a = hyena_mixer(hy_u, hy_short_w[l], kf, hy_bias[l])
        q, k, v = jnp.split(na_qkv, 3, axis=-1)
        y_b = neighbourhood_attention(q, k, v, na_rpb[l])
        b_gate, c_gate, x_in = jnp.split(sc_u, 3, axis=-1)
        y_c = short_conv_mixer(b_gate, c_gate, x_in, sc_conv_w[l])
        gates = jax.nn.sigmoid(gate_pre.reshape(B, L, N_BRANCH, D_MODEL) + gate_bias[l])
        merged = (gates[:, :, 0] * (y_a @ w_branch[l, 0])
                  + gates[:, :, 1] * (y_b @ w_branch[l, 1])
                  + gates[:, :, 2] * (y_c @ w_branch[l, 2]))
        x = x + rms_norm(merged @ w_out[l], g[1])
        h = rms_norm(x, g[2])
        mem_n = rms_norm(mem, mem_norm[l])
        x = x + rms_norm(memory_cross_attention(h, mem_n, xa_wq[l], xa_wkv[l], xa_wo[l]), g[3])
        h = rms_norm(x, g[4])
        x = x + rms_norm(conv_glu_ffn(h, ffn_up[l], ffn_conv[l], ffn_down[l]), g[5])
    return x
```

```cpp
#include <hip/hip_runtime.h>
#include <cstdio>
#include <cstdint>

#ifndef MK_ONE_LAUNCH
#define MK_ONE_LAUNCH 1
#endif

namespace pg8 {
#define PG8_LAS __attribute__((address_space(3)))
typedef unsigned short bf16_t;
typedef short bf16x8 __attribute__((ext_vector_type(8)));
typedef float f32x4 __attribute__((ext_vector_type(4)));
typedef float f32x2 __attribute__((ext_vector_type(2)));
typedef unsigned u32x4 __attribute__((ext_vector_type(4)));
constexpr int BM = 256, BK = 64, HALF = 128, HTB = HALF * BK * 2, STAGE_BYTES = 8 * HTB, NXCD = 8, WGM = 8;

__host__ __device__ __forceinline__ int lds_byte(int r, int c) { const int st = (r >> 4) * 2 + (c >> 5), rr = r & 15, cc = c & 31, ob = rr * 64 + cc * 2; return st * 1024 + (ob ^ (((ob >> 9) & 1) << 5)); }
__host__ __device__ __forceinline__ void stage_rc(int b, int& R, int& C) { const int st = b / 1024, sb = b % 1024, swz = sb ^ (((sb >> 9) & 1) << 5); R = (st >> 1) * 16 + swz / 64; C = (st & 1) * 32 + (swz % 64) / 2; }
__host__ __device__ __forceinline__ int perm32(int rho) { const int n = rho >> 4, i = rho & 15; return 8 * (i >> 2) + 4 * n + (i & 3); }

struct Unit { int pm, pn, z; };
struct Gemm { const bf16_t* A; const bf16_t* Bt; int lda, ldb, K, nz0; long sA0, sA1, sB0, sB1; };
__device__ __forceinline__ long zoff(int z, int nz0, long s0, long s1) { return (long)(z / nz0) * s1 + (long)(z % nz0) * s0; }

struct GenOrder {
    int nM, nN, nZ, nwg, G, c;
    __host__ __device__ void init(int nM_, int nN_, int nZ_, int G_, int c_) { nM = nM_; nN = nN_; nZ = nZ_; nwg = nM * nN * nZ; G = G_; c = c_; }
    __host__ __device__ bool next(int i, Unit& u) const {
        const long L = (long)i * G + c; if (L >= nwg) return false;
        int wgid = (int)L; { const int q = nwg / NXCD, r = nwg % NXCD, xcd = wgid % NXCD, off = wgid / NXCD; wgid = (xcd < r ? xcd * (q + 1) : r * (q + 1) + (xcd - r) * q) + off; }
        const int nMz = nM * nZ, nig = WGM * nN, gid = wgid / nig, fm = gid * WGM, gsz = (nMz - fm) < WGM ? (nMz - fm) : WGM;
        const int pmz = fm + ((wgid % nig) % gsz); u.pm = pmz % nM; u.z = pmz / nM; u.pn = (wgid % nig) / gsz; return true;
    }
};
struct RepeatOrder {
    GenOrder base; int nrep;
    __host__ __device__ void init(int nM_, int nN_, int nrep_, int G_, int c_) { base.init(nM_, nN_, 1, G_, c_); nrep = nrep_; }
    __host__ __device__ bool next(int i, Unit& u) const { if (!base.next(i / nrep, u)) return false; u.z = i % nrep; return true; }
};

__device__ __forceinline__ unsigned cvt_pk_bf16(float lo, float hi) { unsigned r; asm volatile("v_cvt_pk_bf16_f32 %0, %1, %2" : "=v"(r) : "v"(lo), "v"(hi)); return r; }
__device__ __forceinline__ float bf_lo(unsigned w) { return __uint_as_float(w << 16); }
__device__ __forceinline__ float bf_hi(unsigned w) { return __uint_as_float(w & 0xffff0000u); }

struct EpiBf16G {
    static constexpr bool PERM = true;
    bf16_t* O; int ldc; int nz0; long sC0, sC1; int split_cols; long split_stride; float scale;
    __device__ __forceinline__ void operator()(const f32x4 (&acc)[2][2][4][2], const Unit& u, int wr, int wc, int fr, int fq) const {
        const int row0 = u.pm * BM + wr * 64 + fr; int colt = u.pn * BM; bf16_t* base = O + zoff(u.z, nz0, sC0, sC1);
        if (split_cols) { const int t = colt / split_cols; base += (long)t * split_stride; colt -= t * split_cols; }
        const int col0 = colt + wc * 32 + 8 * fq;
#pragma unroll
        for (int ai = 0; ai < 2; ++ai)
#pragma unroll
            for (int m = 0; m < 4; ++m) { bf16_t* rowp = base + (size_t)(row0 + ai * HALF + m * 16) * ldc + col0;
#pragma unroll
                for (int bj = 0; bj < 2; ++bj) { const f32x4 v0 = acc[ai][bj][m][0] * scale, v1 = acc[ai][bj][m][1] * scale;
                    u32x4 w; w.x = cvt_pk_bf16(v0[0], v0[1]); w.y = cvt_pk_bf16(v0[2], v0[3]); w.z = cvt_pk_bf16(v1[0], v1[1]); w.w = cvt_pk_bf16(v1[2], v1[3]);
                    *(u32x4*)(rowp + bj * HALF) = w; } }
    }
};
struct EpiF32G {
    static constexpr bool PERM = false;
    float* C; int ldc; long sCz;
    __device__ __forceinline__ void operator()(const f32x4 (&acc)[2][2][4][2], const Unit& u, int wr, int wc, int fr, int fq) const {
        const int row0 = u.pm * BM + wr * 64 + fr, col0 = u.pn * BM + wc * 32 + 4 * fq; float* base = C + (long)u.z * sCz;
#pragma unroll
        for (int ai = 0; ai < 2; ++ai)
#pragma unroll
            for (int m = 0; m < 4; ++m) { float* rowp = base + (size_t)(row0 + ai * HALF + m * 16) * ldc + col0;
#pragma unroll
                for (int bj = 0; bj < 2; ++bj)
#pragma unroll
                    for (int n = 0; n < 2; ++n) *(f32x4*)(rowp + bj * HALF + n * 16) = acc[ai][bj][m][n]; }
    }
};
struct EpiGate {
    static constexpr bool PERM = true;
    const bf16_t* Bsrc; long sBz; bf16_t* merged; const float* gbias;
    __device__ __forceinline__ void operator()(const f32x4 (&acc)[2][2][4][2], const Unit& u, int wr, int wc, int fr, int fq) const {
        const int row0 = u.pm * BM + wr * 64 + fr, col0 = u.pn * BM + wc * 32 + 8 * fq; const bf16_t* bsrc = Bsrc + (long)u.z * sBz; const float* gb = gbias + u.z * 1024;
#pragma unroll
        for (int bj = 0; bj < 2; ++bj) { const f32x4 g0 = *(const f32x4*)(gb + col0 + bj * HALF), g1 = *(const f32x4*)(gb + col0 + bj * HALF + 4);
#pragma unroll
            for (int ai = 0; ai < 2; ++ai)
#pragma unroll
                for (int m = 0; m < 4; ++m) { const size_t off = (size_t)(row0 + ai * HALF + m * 16) * 1024 + col0 + bj * HALF;
                    const u32x4 bw = *(const u32x4*)(bsrc + off);
                    const f32x4 a0 = acc[ai][bj][m][0] + g0, a1 = acc[ai][bj][m][1] + g1; float r[8];
                    r[0] = bf_lo(bw.x) / (1.f + __expf(-a0[0])); r[1] = bf_hi(bw.x) / (1.f + __expf(-a0[1])); r[2] = bf_lo(bw.y) / (1.f + __expf(-a0[2])); r[3] = bf_hi(bw.y) / (1.f + __expf(-a0[3]));
                    r[4] = bf_lo(bw.z) / (1.f + __expf(-a1[0])); r[5] = bf_hi(bw.z) / (1.f + __expf(-a1[1])); r[6] = bf_lo(bw.w) / (1.f + __expf(-a1[2])); r[7] = bf_hi(bw.w) / (1.f + __expf(-a1[3]));
                    if (u.z != 0) { const u32x4 ow = *(const u32x4*)(merged + off);
                        r[0] += bf_lo(ow.x); r[1] += bf_hi(ow.x); r[2] += bf_lo(ow.y); r[3] += bf_hi(ow.y); r[4] += bf_lo(ow.z); r[5] += bf_hi(ow.z); r[6] += bf_lo(ow.w); r[7] += bf_hi(ow.w); }
                    u32x4 w; w.x = cvt_pk_bf16(r[0], r[1]); w.y = cvt_pk_bf16(r[2], r[3]); w.z = cvt_pk_bf16(r[4], r[5]); w.w = cvt_pk_bf16(r[6], r[7]);
                    *(u32x4*)(merged + off) = w; } }
    }
};

template <class Epi, class Sched, bool ALIGN_EPI = true>
__device__ __forceinline__ void gemm_phase(PG8_LAS unsigned char* lds, const Gemm g, const Sched& S, const Epi& E, const int tid) {
    const int wid = __builtin_amdgcn_readfirstlane(tid >> 6), lane = tid & 63, wr = wid >> 2, wc = wid & 3, fr = lane & 15, fq = lane >> 4;
    const int nt = g.K / BK;
    unsigned voffA[2], voffB[2];
#pragma unroll
    for (int i = 0; i < 2; ++i) { int R, C; stage_rc(tid * 16 + i * 8192, R, C); const int Rb = Epi::PERM ? ((R & ~31) + perm32(R & 31)) : R;
        voffA[i] = (unsigned)(R * g.lda + C) * 2u; voffB[i] = (unsigned)(Rb * g.ldb + C) * 2u; }
    const size_t kstep = (size_t)(BK * 2);
    const size_t hstepA = (size_t)HALF * g.lda * 2, hstepB = (size_t)HALF * g.ldb * 2;
    const unsigned ldsw = (unsigned)wid * 1024u;
    const int aoff = lds_byte(wr * 64 + fr, fq * 8), boff = lds_byte(wc * 32 + fr, fq * 8);
#define PG8_SA(b, h) (((b) * 2 + (h)) * HTB)
#define PG8_SB(b, h) ((4 + (b) * 2 + (h)) * HTB)
#define PG8_STAGE(bufoff, gbase, voff) do { _Pragma("unroll") for (int _i = 0; _i < 2; ++_i) \
        __builtin_amdgcn_global_load_lds((const unsigned*)((const char*)(gbase) + (voff)[_i]), (PG8_LAS unsigned*)(lds + (bufoff) + ldsw + _i * 8192), 16, 0, 0); } while (0)
#define PG8_LDA(dst, b, h) do { _Pragma("unroll") for (int m = 0; m < 4; ++m) _Pragma("unroll") for (int k = 0; k < 2; ++k) dst[m][k] = *(const PG8_LAS bf16x8*)(lds + PG8_SA(b, h) + aoff + m * 2048 + k * 1024); } while (0)
#define PG8_LDB(dst, b, h) do { _Pragma("unroll") for (int n = 0; n < 2; ++n) _Pragma("unroll") for (int k = 0; k < 2; ++k) dst[n][k] = *(const PG8_LAS bf16x8*)(lds + PG8_SB(b, h) + boff + n * 2048 + k * 1024); } while (0)
#define PG8_MMA(ai, bj, At, Bt) do { __builtin_amdgcn_s_setprio(1); _Pragma("unroll") for (int m = 0; m < 4; ++m) _Pragma("unroll") for (int n = 0; n < 2; ++n) _Pragma("unroll") for (int k = 0; k < 2; ++k) \
        acc[ai][bj][m][n] = __builtin_amdgcn_mfma_f32_16x16x32_bf16(Bt[n][k], At[m][k], acc[ai][bj][m][n], 0, 0, 0); __builtin_amdgcn_s_setprio(0); } while (0)
#define PG8_WAIT_V(n) asm volatile("s_waitcnt vmcnt(" #n ")" ::: "memory")
#define PG8_WAIT_L(n) asm volatile("s_waitcnt lgkmcnt(" #n ")" ::: "memory")
#define PG8_BAR __builtin_amdgcn_s_barrier()
#define PG8_SCHED __builtin_amdgcn_sched_barrier(0)
    Unit cur, nxt; int ui = 0;
    if (!S.next(0, cur)) return;
    f32x4 acc[2][2][4][2];
#pragma unroll
    for (int a = 0; a < 2; ++a)
#pragma unroll
        for (int b = 0; b < 2; ++b)
#pragma unroll
            for (int m = 0; m < 4; ++m)
#pragma unroll
                for (int n = 0; n < 2; ++n) acc[a][b][m][n] = (f32x4){0.f, 0.f, 0.f, 0.f};
    bf16x8 At[4][2], B0[2][2], B1[2][2];
    const char* cA = (const char*)(g.A + zoff(cur.z, g.nz0, g.sA0, g.sA1)) + (size_t)cur.pm * 2 * hstepA;
    const char* cB = (const char*)(g.Bt + zoff(cur.z, g.nz0, g.sB0, g.sB1)) + (size_t)cur.pn * 2 * hstepB;
    PG8_STAGE(PG8_SB(0, 0), cB, voffB); PG8_STAGE(PG8_SB(0, 1), cB + hstepB, voffB); PG8_STAGE(PG8_SA(0, 0), cA, voffA); PG8_STAGE(PG8_SA(0, 1), cA + hstepA, voffA);
    if (wr == 1) PG8_BAR;
    PG8_WAIT_V(2); PG8_BAR;
    PG8_STAGE(PG8_SB(1, 0), cB + kstep, voffB); PG8_STAGE(PG8_SA(1, 0), cA + kstep, voffA); PG8_STAGE(PG8_SB(1, 1), cB + hstepB + kstep, voffB);
    PG8_WAIT_V(6); PG8_BAR;
    for (;;) {
        const bool has_next = S.next(ui + 1, nxt);
        const char* nA = has_next ? (const char*)(g.A + zoff(nxt.z, g.nz0, g.sA0, g.sA1)) + (size_t)nxt.pm * 2 * hstepA : cA;
        const char* nB = has_next ? (const char*)(g.Bt + zoff(nxt.z, g.nz0, g.sB0, g.sB1)) + (size_t)nxt.pn * 2 * hstepB : cB;
        for (int t = 0; t < nt; t += 2) {
            const bool last = (t == nt - 2);
            const char* a1 = cA + (size_t)(t + 1) * kstep;
            const char* a2 = last ? nA : cA + (size_t)(t + 2) * kstep; const char* b2 = last ? nB : cB + (size_t)(t + 2) * kstep;
            const char* a3 = a2 + kstep; const char* b3 = b2 + kstep;
            PG8_LDB(B0, 0, 0); PG8_LDB(B1, 0, 1); PG8_SCHED; PG8_LDA(At, 0, 0); PG8_STAGE(PG8_SA(1, 1), a1 + hstepA, voffA);
            PG8_WAIT_V(8); PG8_WAIT_L(0); PG8_BAR; PG8_MMA(0, 0, At, B0); PG8_MMA(0, 1, At, B1); PG8_BAR; PG8_SCHED;
            PG8_LDA(At, 0, 1); PG8_STAGE(PG8_SB(0, 0), b2, voffB); PG8_STAGE(PG8_SB(0, 1), b2 + hstepB, voffB); PG8_STAGE(PG8_SA(0, 0), a2, voffA);
            PG8_WAIT_V(8); PG8_WAIT_L(0); PG8_BAR; PG8_MMA(1, 0, At, B0); PG8_MMA(1, 1, At, B1); PG8_BAR; PG8_SCHED;
            PG8_LDB(B0, 1, 0); PG8_LDB(B1, 1, 1); PG8_SCHED; PG8_LDA(At, 1, 0); PG8_STAGE(PG8_SA(0, 1), a2 + hstepA, voffA);
            PG8_WAIT_V(8); PG8_WAIT_L(0); PG8_BAR; PG8_MMA(0, 0, At, B0); PG8_MMA(0, 1, At, B1); PG8_BAR; PG8_SCHED;
            PG8_LDA(At, 1, 1); PG8_STAGE(PG8_SB(1, 0), b3, voffB); PG8_STAGE(PG8_SB(1, 1), b3 + hstepB, voffB); PG8_STAGE(PG8_SA(1, 0), a3, voffA);
            PG8_WAIT_V(8); PG8_WAIT_L(0); PG8_BAR; PG8_MMA(1, 0, At, B0); PG8_MMA(1, 1, At, B1); PG8_BAR; PG8_SCHED;
        }
        if constexpr (ALIGN_EPI) { if (wr == 0) PG8_BAR; }
        E(acc, cur, wr, wc, fr, fq);
        if (!has_next) break;
#pragma unroll
        for (int a = 0; a < 2; ++a)
#pragma unroll
            for (int b = 0; b < 2; ++b)
#pragma unroll
                for (int m = 0; m < 4; ++m)
#pragma unroll
                    for (int n = 0; n < 2; ++n) acc[a][b][m][n] = (f32x4){0.f, 0.f, 0.f, 0.f};
        cur = nxt; cA = nA; cB = nB; ++ui;
        if constexpr (ALIGN_EPI) { if (wr == 1) PG8_BAR; }
    }
    PG8_WAIT_V(0);
    if constexpr (!ALIGN_EPI) { if (wr == 0) PG8_BAR; }
    PG8_BAR;
#undef PG8_SA
#undef PG8_SB
#undef PG8_STAGE
#undef PG8_LDA
#undef PG8_LDB
#undef PG8_MMA
#undef PG8_WAIT_V
#undef PG8_WAIT_L
#undef PG8_BAR
#undef PG8_SCHED
}
}

constexpr int NWAVES = 8, NTHR = NWAVES * 64;
constexpr int NB = 8, SEQ = 2048, D = 1024, T = NB * SEQ, NMEM = 256, PROJW = 7680, HYW = 512, DFF = 2816, DEPTH = 2;
constexpr int TM = NB * NMEM;
constexpr float EPS = 1e-6f;
constexpr size_t MiB = 1u << 20;
constexpr size_t WS_CTL = 0, CTL_ZERO_BYTES = 1 * MiB;
constexpr size_t WS_WB = 1 * MiB;
constexpr size_t WS_FILT = 21 * MiB;
constexpr size_t WS_XN = 37 * MiB;
constexpr size_t WS_BIG = 69 * MiB;
constexpr size_t WS_END = 256 * MiB;

typedef unsigned short bf16;
typedef unsigned v4u __attribute__((ext_vector_type(4)));
typedef unsigned v2u __attribute__((ext_vector_type(2)));
typedef float f32x4 __attribute__((ext_vector_type(4)));
#define LAS __attribute__((address_space(3)))
#define LDS_WAIT() asm volatile("s_waitcnt lgkmcnt(0)" ::: "memory")
__device__ __forceinline__ unsigned f2bf(float f) { unsigned u = __builtin_bit_cast(unsigned, f); return (u + 0x7fffu + ((u >> 16) & 1u)) >> 16; }
__device__ __forceinline__ unsigned pk2(float lo, float hi) { return f2bf(lo) | (f2bf(hi) << 16); }
__device__ __forceinline__ float bf2f(unsigned short h) { return __uint_as_float(((unsigned)h) << 16); }
__device__ __forceinline__ float bflo(unsigned w) { return __uint_as_float(w << 16); }
__device__ __forceinline__ float bfhi(unsigned w) { return __uint_as_float(w & 0xffff0000u); }
__device__ __forceinline__ int hw_lane() { int l; asm volatile("v_mbcnt_lo_u32_b32 %0, -1, 0\n\tv_mbcnt_hi_u32_b32 %0, -1, %0" : "=v"(l)); return l; }
__device__ __forceinline__ float wave_sum(float v) {
#pragma unroll
    for (int o = 1; o < 64; o <<= 1) v += __shfl_xor(v, o);
    return v;
}
__device__ __forceinline__ float wave_max(float v) {
#pragma unroll
    for (int o = 1; o < 64; o <<= 1) v = fmaxf(v, __shfl_xor(v, o));
    return v;
}

__device__ __forceinline__ void transpose_item(const float* W, int K, int N, bf16* WT, int row_off, LAS float* scr, int item, int lane) {
    const int nblk = N / 32, kb = item / nblk, nb = item % nblk, k0 = 64 * kb, n0 = 32 * nb;
#pragma unroll 8
    for (int i = 0; i < 32; ++i) { const int kk = 2 * i + (lane >> 5); scr[kk * 33 + (lane & 31)] = W[(size_t)(k0 + kk) * N + n0 + (lane & 31)]; }
    LDS_WAIT(); asm volatile("" ::: "memory");
    const int c = lane & 7;
#pragma unroll
    for (int j = 0; j < 4; ++j) { const int n = (lane >> 3) + 8 * j; const LAS float* s = scr + (8 * c) * 33 + n;
        v4u o; o.x = pk2(s[0 * 33], s[1 * 33]); o.y = pk2(s[2 * 33], s[3 * 33]); o.z = pk2(s[4 * 33], s[5 * 33]); o.w = pk2(s[6 * 33], s[7 * 33]);
        *(v4u*)(WT + (size_t)(row_off + n0 + n) * K + k0 + 8 * c) = o; }
    LDS_WAIT(); asm volatile("" ::: "memory");
}
__device__ __forceinline__ void convert_weight(const float* W, int K, int N, bf16* WT, LAS unsigned char* lds, int gw, int NGW, int wave, int lane) {
    LAS float* scr = (LAS float*)(lds + wave * 16384);
    const int nitems = (K / 64) * (N / 32);
    for (int it = gw; it < nitems; it += NGW) transpose_item(W, K, N, WT, 0, scr, it, lane);
}
__device__ __forceinline__ void rms_row_to_bf16(const float* xrow, const float* g, bf16* orow, int lane) {
    const f32x4* xr = (const f32x4*)xrow + lane; const f32x4* gr = (const f32x4*)g + lane;
    f32x4 v[4]; float s = 0.f;
#pragma unroll
    for (int j = 0; j < 4; ++j) { v[j] = xr[64 * j]; s += (v[j].x * v[j].x + v[j].y * v[j].y) + (v[j].z * v[j].z + v[j].w * v[j].w); }
    const float rstd = 1.0f / sqrtf(wave_sum(s) * (1.f / D) + EPS);
    unsigned long long* o8 = (unsigned long long*)orow + lane;
#pragma unroll
    for (int j = 0; j < 4; ++j) { const f32x4 gg = gr[64 * j]; o8[64 * j] = (unsigned long long)pk2(v[j].x * rstd * gg.x, v[j].y * rstd * gg.y) | ((unsigned long long)pk2(v[j].z * rstd * gg.z, v[j].w * rstd * gg.w) << 32); }
}
__device__ __forceinline__ void resid_row(const float* trow, const float* xold, float* xout, const float* ga, const float* gb, bf16* xnrow, int lane) {
    const f32x4* tr = (const f32x4*)trow + lane; const f32x4* xo = (const f32x4*)xold + lane; const f32x4* gar = (const f32x4*)ga + lane;
    f32x4 v[4]; float s = 0.f;
#pragma unroll
    for (int j = 0; j < 4; ++j) { v[j] = tr[64 * j]; s += (v[j].x * v[j].x + v[j].y * v[j].y) + (v[j].z * v[j].z + v[j].w * v[j].w); }
    const float rstd = 1.0f / sqrtf(wave_sum(s) * (1.f / D) + EPS);
    float s2 = 0.f;
#pragma unroll
    for (int j = 0; j < 4; ++j) { const f32x4 gg = gar[64 * j]; const f32x4 xv = xo[64 * j]; v[j] = xv + v[j] * rstd * gg; s2 += (v[j].x * v[j].x + v[j].y * v[j].y) + (v[j].z * v[j].z + v[j].w * v[j].w); }
    f32x4* xw = (f32x4*)xout + lane;
#pragma unroll
    for (int j = 0; j < 4; ++j) xw[64 * j] = v[j];
    if (gb) {
        const float rstd2 = 1.0f / sqrtf(wave_sum(s2) * (1.f / D) + EPS); const f32x4* gbr = (const f32x4*)gb + lane;
        unsigned long long* o8 = (unsigned long long*)xnrow + lane;
#pragma unroll
        for (int j = 0; j < 4; ++j) { const f32x4 gg = gbr[64 * j]; o8[64 * j] = (unsigned long long)pk2(v[j].x * rstd2 * gg.x, v[j].y * rstd2 * gg.y) | ((unsigned long long)pk2(v[j].z * rstd2 * gg.z, v[j].w * rstd2 * gg.w) << 32); }
    }
}

__device__ __forceinline__ void hyena_filter_unit(int unit, const float* w1, const float* b1, const float* w2, const float* b2, const float* w3, const float* freq, float* FILT, LAS unsigned char* lds, int tid) {
    LAS float* zL = (LAS float*)lds;
    LAS float* h1L = zL + 32 * 33;
    LAS float* h2L = h1L + 32 * 64;
    LAS float* oL = h2L + 32 * 64;
    const int pt = unit >> 2, cg = unit & 3, p0 = pt * 32;
    for (int i = tid; i < 32 * 33; i += NTHR) { const int p = i / 33, f = i % 33; const int pos = p0 + p; float val;
        if (f == 0) val = (float)pos / (float)(SEQ - 1);
        else { const int band = (f - 1) & 15; const float fb = 1e-4f + (float)band * ((15.0f - 1e-4f) / 15.0f); const float w = (6.283185307179586f * (float)pos) / (float)SEQ; const float a = fb * w;
            val = (f <= 16) ? cosf(a) : -sinf(a); }
        zL[p * 33 + f] = val; }
    __syncthreads();
    for (int i = tid; i < 32 * 64; i += NTHR) { const int p = i >> 6, k = i & 63; float s = b1[k];
        for (int f = 0; f < 33; ++f) s += zL[p * 33 + f] * w1[f * 64 + k];
        h1L[p * 64 + k] = sinf(freq[k] * s); }
    __syncthreads();
    for (int i = tid; i < 32 * 64; i += NTHR) { const int p = i >> 6, k = i & 63; float s = b2[k];
        for (int f = 0; f < 64; ++f) s += h1L[p * 64 + f] * w2[f * 64 + k];
        h2L[k * 32 + p] = sinf(freq[64 + k] * s); }
    __syncthreads();
    {
        const int col = cg * 512 + tid; const int c = col & 511;
        float sacc[32];
#pragma unroll
        for (int p = 0; p < 32; ++p) sacc[p] = 0.f;
#pragma unroll 1
        for (int k = 0; k < 64; ++k) { const float wk = w3[(size_t)k * 2048 + col];
#pragma unroll
            for (int p = 0; p < 32; p += 4) { const f32x4 hv = *(const LAS f32x4*)(h2L + k * 32 + p);
                sacc[p] += hv.x * wk; sacc[p + 1] += hv.y * wk; sacc[p + 2] += hv.z * wk; sacc[p + 3] += hv.w * wk; } }
        const float d0 = 4.605170185988091f / 1.5f, d1 = 4.605170185988091f / 0.3f;
        const float delta = d0 + (float)c * ((d1 - d0) / 511.0f);
#pragma unroll
        for (int p = 0; p < 32; ++p) { const float tt = (float)(p0 + p) / (float)(SEQ - 1); oL[tid * 33 + p] = sacc[p] * expf(-tt * delta); }
    }
    __syncthreads();
    for (int i = tid; i < 512 * 32; i += NTHR) { const int jc = i >> 5, p = i & 31; const int j = cg * 512 + jc, dir = j >> 10, o = (j >> 9) & 1, c = j & 511; const int pos = p0 + p;
        const float val = oL[jc * 33 + p]; float* dst = FILT + ((size_t)(c * 2 + o)) * 4096;
        if (dir == 0) dst[2048 + pos] = val; else if (pos >= 1) dst[2048 - pos] = val; }
    __syncthreads();
}

__device__ __forceinline__ void hyena_unit(int c, bf16* HYT, const float* FILT, const float* short_w, const float* hbias, LAS unsigned char* lds, int tid) {
    LAS float* vS = (LAS float*)lds;
    LAS float* gS = vS + 2048 * 8;
    const bf16* rv = HYT + (size_t)c * T; const bf16* r1 = HYT + (size_t)(512 + c) * T; bf16* r2 = HYT + (size_t)(1024 + c) * T;
    const float wv0 = short_w[c], wv1 = short_w[1536 + c], wv2 = short_w[3072 + c];
    const float wa0 = short_w[512 + c], wa1 = short_w[1536 + 512 + c], wa2 = short_w[3072 + 512 + c];
    const float wb0 = short_w[1024 + c], wb1 = short_w[1536 + 1024 + c], wb2 = short_w[3072 + 1024 + c];
    const float bias0 = hbias[c], bias1 = hbias[512 + c];
    float x1c[4][8], x2c[4][8], acc[4][8];
#pragma unroll
    for (int k = 0; k < 4; ++k)
#pragma unroll
        for (int b = 0; b < 8; ++b) { const int t = tid + 512 * k; const size_t m = (size_t)b * SEQ + t; const bool lo = t > 0, hi = t < SEQ - 1;
            const float vm = lo ? bf2f(rv[m - 1]) : 0.f, v0 = bf2f(rv[m]), vp = hi ? bf2f(rv[m + 1]) : 0.f;
            const float am = lo ? bf2f(r1[m - 1]) : 0.f, a0 = bf2f(r1[m]), ap = hi ? bf2f(r1[m + 1]) : 0.f;
            const float bm = lo ? bf2f(r2[m - 1]) : 0.f, b0 = bf2f(r2[m]), bp = hi ? bf2f(r2[m + 1]) : 0.f;
            vS[t * 8 + b] = wv0 * vm + wv1 * v0 + wv2 * vp; x1c[k][b] = wa0 * am + wa1 * a0 + wa2 * ap; x2c[k][b] = wb0 * bm + wb1 * b0 + wb2 * bp; }
#pragma unroll 1
    for (int o = 0; o < 2; ++o) {
        const float* gsrc = FILT + ((size_t)(c * 2 + o)) * 4096;
        for (int i = tid; i < 4096; i += NTHR) gS[i] = (i == 0) ? 0.f : gsrc[i];
        __syncthreads();
#pragma unroll
        for (int k = 0; k < 4; ++k)
#pragma unroll
            for (int b = 0; b < 8; ++b) acc[k][b] = 0.f;
        const LAS float* gp = gS + tid + 2048;
#pragma unroll 2
        for (int s = 0; s < SEQ; ++s) {
            const f32x4 va = *(const LAS f32x4*)(vS + s * 8), vb = *(const LAS f32x4*)(vS + s * 8 + 4);
#pragma unroll
            for (int k = 0; k < 4; ++k) { const float gk = gp[512 * k - s];
                acc[k][0] += gk * va.x; acc[k][1] += gk * va.y; acc[k][2] += gk * va.z; acc[k][3] += gk * va.w;
                acc[k][4] += gk * vb.x; acc[k][5] += gk * vb.y; acc[k][6] += gk * vb.z; acc[k][7] += gk * vb.w; }
        }
        const float bias = o == 0 ? bias0 : bias1;
#pragma unroll
        for (int k = 0; k < 4; ++k)
#pragma unroll
            for (int b = 0; b < 8; ++b) { const int t = tid + 512 * k; const float own = vS[t * 8 + b]; const float r = acc[k][b] + bias * own; acc[k][b] = (o == 0 ? x1c[k][b] : x2c[k][b]) * r; }
        __syncthreads();
        if (o == 0) {
#pragma unroll
            for (int k = 0; k < 4; ++k)
#pragma unroll
                for (int b = 0; b < 8; ++b) vS[(tid + 512 * k) * 8 + b] = acc[k][b];
        } else {
#pragma unroll
            for (int k = 0; k < 4; ++k)
#pragma unroll
                for (int b = 0; b < 8; ++b) r2[(size_t)b * SEQ + tid + 512 * k] = (bf16)f2bf(acc[k][b]);
        }
    }
    __syncthreads();
}

__device__ __forceinline__ void na_item(int item, bf16* NAQ, const bf16* NAK, const bf16* NAV, const float* rpb, int lane) {
    const int h = item & 7, m = item >> 3, b = m >> 11, t = m & 2047, r = t >> 6, cc = t & 63;
    int rs = r - 4; rs = rs < 0 ? 0 : (rs > 24 ? 24 : rs);
    int cs = cc - 8; cs = cs < 0 ? 0 : (cs > 48 ? 48 : cs);
    const v4u* qp = (const v4u*)(NAQ + (size_t)m * 512 + h * 64);
    v4u q[8];
#pragma unroll
    for (int i = 0; i < 8; ++i) q[i] = qp[i];
    float sc[2];
#pragma unroll
    for (int kq = 0; kq < 2; ++kq) { const int kk = lane + 64 * kq, i = kk >> 4, j = kk & 15; const int mk = b * SEQ + (rs + i) * 64 + cs + j;
        const v4u* kp = (const v4u*)(NAK + (size_t)mk * 512 + h * 64); float d = 0.f;
#pragma unroll
        for (int e = 0; e < 8; ++e) { const v4u kv = kp[e]; const v4u qv = q[e];
            d += bflo(qv.x) * bflo(kv.x) + bfhi(qv.x) * bfhi(kv.x) + bflo(qv.y) * bflo(kv.y) + bfhi(qv.y) * bfhi(kv.y) + bflo(qv.z) * bflo(kv.z) + bfhi(qv.z) * bfhi(kv.z) + bflo(qv.w) * bflo(kv.w) + bfhi(qv.w) * bfhi(kv.w); }
        const int dr = (rs + i) - r + 7, dc = (cs + j) - cc + 15;
        sc[kq] = d * 0.125f + rpb[(h * 15 + dr) * 31 + dc]; }
    const float mx = wave_max(fmaxf(sc[0], sc[1]));
    const float e0 = __expf(sc[0] - mx), e1 = __expf(sc[1] - mx);
    const float inv = 1.0f / wave_sum(e0 + e1);
    const float p0 = e0 * inv, p1 = e1 * inv;
    float o = 0.f;
#pragma unroll 4
    for (int kk = 0; kk < 128; ++kk) { const float p = __shfl(kk < 64 ? p0 : p1, kk & 63); const int i = kk >> 4, j = kk & 15; const int mk = b * SEQ + (rs + i) * 64 + cs + j;
        o += p * bf2f(NAV[(size_t)mk * 512 + h * 64 + lane]); }
    NAQ[(size_t)m * 512 + h * 64 + lane] = (bf16)f2bf(o);
}

__device__ __forceinline__ void sc_item(int item, bf16* SCB, const bf16* SCC, const bf16* SCX, const float* w) {
    const int m = item >> 6, ch = (item & 63) * 8, t = m & 2047;
    const size_t off = (size_t)m * 512 + ch;
    const v4u bw = *(const v4u*)(SCB + off);
    float accv[8];
#pragma unroll
    for (int e = 0; e < 8; ++e) accv[e] = 0.f;
#pragma unroll
    for (int k = 0; k < 3; ++k) { const int tt = t + k - 1; if (tt < 0 || tt >= SEQ) continue;
        const size_t o2 = (size_t)(m + k - 1) * 512 + ch; const v4u cw = *(const v4u*)(SCC + o2), xw = *(const v4u*)(SCX + o2); const float* wk = w + k * 512 + ch;
        accv[0] += wk[0] * bflo(cw.x) * bflo(xw.x); accv[1] += wk[1] * bfhi(cw.x) * bfhi(xw.x); accv[2] += wk[2] * bflo(cw.y) * bflo(xw.y); accv[3] += wk[3] * bfhi(cw.y) * bfhi(xw.y);
        accv[4] += wk[4] * bflo(cw.z) * bflo(xw.z); accv[5] += wk[5] * bfhi(cw.z) * bfhi(xw.z); accv[6] += wk[6] * bflo(cw.w) * bflo(xw.w); accv[7] += wk[7] * bfhi(cw.w) * bfhi(xw.w); }
    v4u o; o.x = pk2(bflo(bw.x) * accv[0], bfhi(bw.x) * accv[1]); o.y = pk2(bflo(bw.y) * accv[2], bfhi(bw.y) * accv[3]); o.z = pk2(bflo(bw.z) * accv[4], bfhi(bw.z) * accv[5]); o.w = pk2(bflo(bw.w) * accv[6], bfhi(bw.w) * accv[7]);
    *(v4u*)(SCB + off) = o;
}

__device__ __forceinline__ void ya_transpose_item(int item, const bf16* YAT, bf16* YA, LAS unsigned char* ldsw, int lane) {
    LAS unsigned short* tl = (LAS unsigned short*)ldsw;
    const int cb = item & 7, tb = item >> 3, c0 = cb * 64, t0 = tb * 64;
#pragma unroll 8
    for (int i = 0; i < 64; ++i) tl[i * 66 + lane] = YAT[(size_t)(c0 + i) * T + t0 + lane];
    LDS_WAIT(); asm volatile("" ::: "memory");
#pragma unroll 8
    for (int i = 0; i < 64; ++i) YA[(size_t)(t0 + i) * 512 + c0 + lane] = tl[lane * 66 + i];
    LDS_WAIT(); asm volatile("" ::: "memory");
}

__device__ __forceinline__ void softmax_row(const float* srow, bf16* prow, int lane) {
    const f32x4 v = ((const f32x4*)srow)[lane];
    const float mx = wave_max(fmaxf(fmaxf(v.x, v.y), fmaxf(v.z, v.w)));
    const float e0 = __expf(v.x - mx), e1 = __expf(v.y - mx), e2 = __expf(v.z - mx), e3 = __expf(v.w - mx);
    const float inv = 1.0f / wave_sum((e0 + e1) + (e2 + e3));
    ((unsigned long long*)prow)[lane] = (unsigned long long)pk2(e0 * inv, e1 * inv) | ((unsigned long long)pk2(e2 * inv, e3 * inv) << 32);
}

__device__ __forceinline__ float gelu_tanh(float x) { const float u = 0.7978845608028654f * (x + 0.044715f * x * x * x); return 0.5f * x * (1.0f + tanhf(u)); }
__device__ __forceinline__ void glu_item(int item, const bf16* U, bf16* ACT, const float* wc) {
    const int row = item / 352, ch = (item % 352) * 8, t = row & 2047;
    float g[8], v[8];
#pragma unroll
    for (int e = 0; e < 8; ++e) { g[e] = 0.f; v[e] = 0.f; }
#pragma unroll
    for (int k = 0; k < 3; ++k) { const int tt = t + k - 1; if (tt < 0 || tt >= SEQ) continue;
        const bf16* ur = U + (size_t)(row + k - 1) * (2 * DFF); const v4u gw = *(const v4u*)(ur + ch), vw = *(const v4u*)(ur + DFF + ch); const float* wg = wc + k * (2 * DFF) + ch; const float* wv = wg + DFF;
        g[0] += wg[0] * bflo(gw.x); g[1] += wg[1] * bfhi(gw.x); g[2] += wg[2] * bflo(gw.y); g[3] += wg[3] * bfhi(gw.y); g[4] += wg[4] * bflo(gw.z); g[5] += wg[5] * bfhi(gw.z); g[6] += wg[6] * bflo(gw.w); g[7] += wg[7] * bfhi(gw.w);
        v[0] += wv[0] * bflo(vw.x); v[1] += wv[1] * bfhi(vw.x); v[2] += wv[2] * bflo(vw.y); v[3] += wv[3] * bfhi(vw.y); v[4] += wv[4] * bflo(vw.z); v[5] += wv[5] * bfhi(vw.z); v[6] += wv[6] * bflo(vw.w); v[7] += wv[7] * bfhi(vw.w); }
    v4u o; o.x = pk2(gelu_tanh(g[0]) * v[0], gelu_tanh(g[1]) * v[1]); o.y = pk2(gelu_tanh(g[2]) * v[2], gelu_tanh(g[3]) * v[3]); o.z = pk2(gelu_tanh(g[4]) * v[4], gelu_tanh(g[5]) * v[5]); o.w = pk2(gelu_tanh(g[6]) * v[6], gelu_tanh(g[7]) * v[7]);
    *(v4u*)(ACT + (size_t)row * DFF + ch) = o;
}


#define XB_TMO      128
#define XB_XCNT(j)  (256  + 64 * (j))
#define XB_XSUB(j)  (1280 + 64 * (j))
#define XB_XGEN(j)  (2304 + 64 * (j))
#define XB_TOP      3328
#define XB_TOPGEN   3392
#define XCD_BAR_WORDS 3456
#define XB_SPIN_CAP (1u << 18)
__device__ __forceinline__ unsigned xb_ld(unsigned* p)              { return __hip_atomic_load(p, __ATOMIC_RELAXED, __HIP_MEMORY_SCOPE_AGENT); }
__device__ __forceinline__ unsigned xb_add(unsigned* p, unsigned v) { return __hip_atomic_fetch_add(p, v, __ATOMIC_RELAXED, __HIP_MEMORY_SCOPE_AGENT); }
__device__ __forceinline__ unsigned xb_xcc_id() { return (unsigned)__builtin_amdgcn_s_getreg((3 << 11) | 20) & 0xFu; }
#define XB_SPIN(cond, bar) do { unsigned _sp = 0; while (cond) { __builtin_amdgcn_s_sleep(1); \
    if ((++_sp & 255u) == 0u) { if (xb_ld(&(bar)[XB_TMO])) break; if (_sp > XB_SPIN_CAP) { atomicAdd(&(bar)[XB_TMO], 1u); break; } } } } while (0)
struct XcdBarrier { unsigned* bar; unsigned x; volatile LAS unsigned* st; };
__device__ __forceinline__ XcdBarrier xcd_barrier_post(unsigned* bar, volatile LAS unsigned* st, bool leader) {
    XcdBarrier b; b.bar = bar; b.x = xb_xcc_id(); b.st = st;
    if (leader) (void)xb_add(&bar[XB_XCNT(b.x)], 1u);
    return b;
}
__device__ __forceinline__ void xcd_barrier_complete(unsigned* bar, unsigned x, unsigned& nloc, unsigned& nx) {
    const unsigned G = gridDim.x * gridDim.y * gridDim.z;
    unsigned sum, cnt, mine, sp = 0u;
    for (;;) {
        sum = 0u; cnt = 0u; mine = 0u;
#pragma unroll
        for (unsigned j = 0; j < 16; ++j) { const unsigned c = xb_ld(&bar[XB_XCNT(j)]); sum += c; cnt += (c > 0u) ? 1u : 0u; mine = (j == x) ? c : mine; }
        if (sum == G) break;
        __builtin_amdgcn_s_sleep(1);
        if ((++sp & 255u) == 0u) { if (xb_ld(&bar[XB_TMO])) break; if (sp > XB_SPIN_CAP) { atomicAdd(&bar[XB_TMO], 1u); break; } }
    }
    nloc = mine > 0u ? mine : 1u; nx = cnt > 0u ? cnt : 1u;
}
__device__ __forceinline__ void xcd_barrier(const XcdBarrier& b, const int wave_s) {
    asm volatile("s_waitcnt vmcnt(0)" ::: "memory");
    __syncthreads();
    if (wave_s == 0 && hw_lane() == 0) {
        unsigned* bar = b.bar;
        __builtin_amdgcn_s_waitcnt(0);
        unsigned nloc = b.st[0], nx = b.st[1];
        if (nloc == 0u) { xcd_barrier_complete(bar, b.x, nloc, nx); b.st[0] = nloc; b.st[1] = nx; }
        const unsigned old = xb_add(&bar[XB_XSUB(b.x)], 1u);
        const unsigned gen = old / nloc;
        if (old + 1u == (gen + 1u) * nloc) {
            __builtin_amdgcn_fence(__ATOMIC_RELEASE, "agent");
            asm volatile("s_waitcnt vmcnt(0)" ::: "memory");
            const unsigned og = xb_add(&bar[XB_TOP], 1u);
            const unsigned tg = og / nx;
            if (og + 1u == (tg + 1u) * nx) xb_add(&bar[XB_TOPGEN], 1u);
            else XB_SPIN(xb_ld(&bar[XB_TOPGEN]) == tg, bar);
            __builtin_amdgcn_fence(__ATOMIC_ACQUIRE, "agent");
            xb_add(&bar[XB_XGEN(b.x)], 1u);
            asm volatile("s_waitcnt vmcnt(0)" ::: "memory");
        } else {
            XB_SPIN(xb_ld(&bar[XB_XGEN(b.x)]) == gen, bar);
            __builtin_amdgcn_fence(__ATOMIC_ACQUIRE, "agent");
            asm volatile("s_waitcnt vmcnt(0)" ::: "memory");
        }
    }
    __syncthreads();
}

constexpr int LDS_BYTES = 147456;
constexpr int PH_PER_LAYER = 22;
struct Args { const float* in[24]; float* out; unsigned char* ws; int layer, pad; };

__device__ __forceinline__ int wave_ticket(LAS unsigned char* lds, int off) {
    volatile LAS unsigned* w = (volatile LAS unsigned*)(lds + off);
    for (int i = 0; i < 32; ++i) w[i] = 0u;
    __syncthreads();
    unsigned t = 0u; if (hw_lane() == 0) t = atomicAdd((unsigned*)(w), 1u);
    return __builtin_amdgcn_readfirstlane((int)t);
}
template <int P>
__device__ __forceinline__ void run_phase(const Args& args, const int l, LAS unsigned char* lds, const int wave_s) {
    int lane_ = hw_lane(); asm volatile("" : "+v"(lane_));
    int wave_ = wave_s; asm volatile("" : "+s"(wave_));
    const int lane = lane_, wave = wave_, tid = wave * 64 + lane;
    const int G = gridDim.x, bx = blockIdx.x;
    const int vcu = (G % 8 == 0) ? (bx % 8) * (G / 8) + bx / 8 : bx;
    const int gw = vcu * NWAVES + wave, NGW = G * NWAVES;
    const int gt = vcu * NTHR + tid, NGT = G * NTHR;
    unsigned char* ws = args.ws;
    const float* x_in = args.in[0]; const float* mem = args.in[1]; const float* norm_gains = args.in[2]; const float* mem_norm = args.in[3];
    const float* w_in = args.in[4]; const float* gate_bias = args.in[5]; const float* hy_short_w = args.in[6]; const float* hy_w1 = args.in[7]; const float* hy_b1 = args.in[8];
    const float* hy_w2 = args.in[9]; const float* hy_b2 = args.in[10]; const float* hy_w3 = args.in[11]; const float* hy_freq = args.in[12]; const float* hy_bias = args.in[13];
    const float* na_rpb = args.in[14]; const float* sc_conv_w = args.in[15]; const float* w_branch = args.in[16]; const float* w_out = args.in[17];
    const float* xa_wq = args.in[18]; const float* xa_wkv = args.in[19]; const float* xa_wo = args.in[20]; const float* ffn_up = args.in[21]; const float* ffn_conv = args.in[22]; const float* ffn_down = args.in[23];
    float* xres = args.out;
    bf16* WB = (bf16*)(ws + WS_WB); float* FILT = (float*)(ws + WS_FILT); bf16* XN = (bf16*)(ws + WS_XN); unsigned char* BIG = ws + WS_BIG;
    bf16* HYT = (bf16*)BIG; bf16* NAQ = (bf16*)(BIG + 48 * MiB); bf16* NAK = (bf16*)(BIG + 64 * MiB); bf16* NAV = (bf16*)(BIG + 80 * MiB);
    bf16* SCB = (bf16*)(BIG + 96 * MiB); bf16* SCC = (bf16*)(BIG + 112 * MiB); bf16* SCX = (bf16*)(BIG + 128 * MiB); bf16* MERGED = (bf16*)(BIG + 144 * MiB);
    bf16* YA = (bf16*)BIG; bf16* B0 = (bf16*)(BIG + 16 * MiB); float* TMP_M = (float*)BIG;
    bf16* w_in_t = WB; bf16* wb_t = WB + (size_t)PROJW * D; bf16* w_out_t = wb_t + (size_t)3 * D * HYW;
    bf16* MEMN = (bf16*)(ws + WS_FILT); bf16* KMEM = MEMN + (size_t)TM * D; bf16* VT = KMEM + (size_t)TM * D;
    bf16* QO = (bf16*)BIG; float* SBUF = (float*)(BIG + 32 * MiB); bf16* PBUF = (bf16*)(BIG + 96 * MiB); float* TMP_X = (float*)(BIG + 32 * MiB);
    bf16* wq_t = WB; bf16* wkv_t = WB + (size_t)D * D; bf16* wo_t = wkv_t + (size_t)2 * D * D;
    bf16* UBUF = (bf16*)BIG; bf16* ACT = (bf16*)(BIG + 88 * MiB); float* TMPH = (float*)(BIG + 132 * MiB);
    bf16* up_t = WB; bf16* down_t = WB + (size_t)2 * DFF * D;

    {
        constexpr int p = P;
        const float* gains = norm_gains + (size_t)l * 6 * D;
        switch (p) {
        case 0: {
            convert_weight(w_in + (size_t)l * D * PROJW, D, PROJW, w_in_t, lds, gw, NGW, wave, lane);
            for (int i = 0; i < 3; ++i) convert_weight(w_branch + ((size_t)l * 3 + i) * HYW * D, HYW, D, wb_t + (size_t)i * D * HYW, lds, gw, NGW, wave, lane);
            convert_weight(w_out + (size_t)l * D * D, D, D, w_out_t, lds, gw, NGW, wave, lane);
            __syncthreads();
            for (int u = vcu; u < 256; u += G) hyena_filter_unit(u, hy_w1 + (size_t)l * 33 * 64, hy_b1 + l * 64, hy_w2 + (size_t)l * 64 * 64, hy_b2 + l * 64, hy_w3 + (size_t)l * 64 * 2048, hy_freq + l * 128, FILT, lds, tid);
            if (l == 0) for (int m = gw; m < T; m += NGW) rms_row_to_bf16(x_in + (size_t)m * D, gains, XN + (size_t)m * D, lane);
        } break;
        case 1: {
            { pg8::Gemm g{w_in_t, XN, D, D, D, 1, 0, 0, 0, 0}; pg8::GenOrder S; S.init(6, 64, 1, G, bx);
              pg8::EpiBf16G E{HYT, T, 1, 0, 0, 0, 0, 1.f}; pg8::gemm_phase(lds, g, S, E, tid); }
            { pg8::Gemm g{XN, w_in_t + (size_t)1536 * D, D, D, D, 1, 0, 0, 0, 0}; pg8::GenOrder S; S.init(64, 12, 1, G, bx);
              pg8::EpiBf16G E{NAQ, 512, 1, 0, 0, 512, (long)T * 512, 1.f}; pg8::gemm_phase(lds, g, S, E, tid); }
        } break;
        case 2: {
            for (int c = vcu; c < 512; c += G) hyena_unit(c, HYT, FILT, hy_short_w + (size_t)l * 3 * 1536, hy_bias + (size_t)l * 2 * 512, lds, tid);
            for (int it = gw; it < T * 8; it += NGW) na_item(it, NAQ, NAK, NAV, na_rpb + (size_t)l * 8 * 15 * 31, lane);
            for (int it = gt; it < T * 64; it += NGT) sc_item(it, SCB, SCC, SCX, sc_conv_w + (size_t)l * 3 * 512);
        } break;
        case 3: {
            for (int it = gw; it < 8 * (T / 64); it += NGW) ya_transpose_item(it, HYT + (size_t)1024 * T, YA, lds + wave * 16384, lane);
        } break;
        case 4: {
            pg8::Gemm g{YA, wb_t, 512, 512, 512, 1, 0, (long)(24 * MiB), 0, (long)D * HYW}; pg8::GenOrder S; S.init(64, 4, 3, G, bx);
            pg8::EpiBf16G E{B0, D, 1, 0, (long)(24 * MiB), 0, 0, 1.f}; pg8::gemm_phase(lds, g, S, E, tid);
        } break;
        case 5: {
            pg8::Gemm g{XN, w_in_t + (size_t)4608 * D, D, D, D, 1, 0, 0, 0, (long)D * D}; pg8::RepeatOrder S; S.init(64, 4, 3, G, bx);
            pg8::EpiGate E{B0, (long)(24 * MiB), MERGED, gate_bias + (size_t)l * 3 * D}; pg8::gemm_phase(lds, g, S, E, tid);
        } break;
        case 6: {
            pg8::Gemm g{MERGED, w_out_t, D, D, D, 1, 0, 0, 0, 0}; pg8::GenOrder S; S.init(64, 4, 1, G, bx);
            pg8::EpiF32G E{TMP_M, D, 0}; pg8::gemm_phase(lds, g, S, E, tid);
        } break;
        case 7: {
            for (int m = gw; m < T; m += NGW) resid_row(TMP_M + (size_t)m * D, (l == 0 ? x_in : xres) + (size_t)m * D, xres + (size_t)m * D, gains + D, gains + 2 * D, XN + (size_t)m * D, lane);
            convert_weight(xa_wq + (size_t)l * D * D, D, D, wq_t, lds, gw, NGW, wave, lane);
            convert_weight(xa_wkv + (size_t)l * D * 2 * D, D, 2 * D, wkv_t, lds, gw, NGW, wave, lane);
            convert_weight(xa_wo + (size_t)l * D * D, D, D, wo_t, lds, gw, NGW, wave, lane);
            for (int m = gw; m < TM; m += NGW) rms_row_to_bf16(mem + (size_t)m * D, mem_norm + (size_t)l * D, MEMN + (size_t)m * D, lane);
        } break;
        case 8: {
            { pg8::Gemm g{XN, wq_t, D, D, D, 1, 0, 0, 0, 0}; pg8::GenOrder S; S.init(64, 4, 1, G, bx);
              pg8::EpiBf16G E{QO, D, 1, 0, 0, 0, 0, 0.0625f}; pg8::gemm_phase(lds, g, S, E, tid); }
            { pg8::Gemm g{MEMN, wkv_t, D, D, D, 1, 0, 0, 0, 0}; pg8::GenOrder S; S.init(8, 4, 1, G, bx);
              pg8::EpiBf16G E{KMEM, D, 1, 0, 0, 0, 0, 1.f}; pg8::gemm_phase(lds, g, S, E, tid); }
            { pg8::Gemm g{wkv_t + (size_t)D * D, MEMN, D, D, D, 1, 0, 0, 0, 0}; pg8::GenOrder S; S.init(4, 8, 1, G, bx);
              pg8::EpiBf16G E{VT, TM, 1, 0, 0, 0, 0, 1.f}; pg8::gemm_phase(lds, g, S, E, tid); }
        } break;
        case 9: {
            pg8::Gemm g{QO, KMEM, D, D, 256, 4, 256, (long)SEQ * D, 256, (long)NMEM * D}; pg8::GenOrder S; S.init(8, 1, 32, G, bx);
            pg8::EpiF32G E{SBUF, 256, (long)SEQ * 256}; pg8::gemm_phase(lds, g, S, E, tid);
        } break;
        case 10: {
            for (int r = gw; r < 32 * SEQ; r += NGW) softmax_row(SBUF + (size_t)r * 256, PBUF + (size_t)r * 256, lane);
        } break;
        case 11: {
            pg8::Gemm g{PBUF, VT, 256, TM, 256, 4, (long)SEQ * 256, (long)4 * SEQ * 256, (long)256 * TM, 256}; pg8::GenOrder S; S.init(8, 1, 32, G, bx);
            pg8::EpiBf16G E{QO, D, 4, 256, (long)SEQ * D, 0, 0, 1.f}; pg8::gemm_phase(lds, g, S, E, tid);
        } break;
        case 12: {
            pg8::Gemm g{QO, wo_t, D, D, D, 1, 0, 0, 0, 0}; pg8::GenOrder S; S.init(64, 4, 1, G, bx);
            pg8::EpiF32G E{TMP_X, D, 0}; pg8::gemm_phase(lds, g, S, E, tid);
        } break;
        case 13: {
            for (int m = gw; m < T; m += NGW) resid_row(TMP_X + (size_t)m * D, xres + (size_t)m * D, xres + (size_t)m * D, gains + 3 * D, gains + 4 * D, XN + (size_t)m * D, lane);
            convert_weight(ffn_up + (size_t)l * D * 2 * DFF, D, 2 * DFF, up_t, lds, gw, NGW, wave, lane);
            convert_weight(ffn_down + (size_t)l * DFF * D, DFF, D, down_t, lds, gw, NGW, wave, lane);
        } break;
        case 14: case 18: {
            const int hf = (p == 18);
            pg8::Gemm g{XN + (size_t)hf * 8192 * D, up_t, D, D, D, 1, 0, 0, 0, 0}; pg8::GenOrder S; S.init(32, 22, 1, G, bx);
            pg8::EpiBf16G E{UBUF, 2 * DFF, 1, 0, 0, 0, 0, 1.f}; pg8::gemm_phase(lds, g, S, E, tid);
        } break;
        case 15: case 19: {
            for (int it = gt; it < 8192 * 352; it += NGT) glu_item(it, UBUF, ACT, ffn_conv + (size_t)l * 3 * 2 * DFF);
        } break;
        case 16: case 20: {
            pg8::Gemm g{ACT, down_t, DFF, DFF, DFF, 1, 0, 0, 0, 0}; pg8::GenOrder S; S.init(32, 4, 1, G, bx);
            pg8::EpiF32G E{TMPH, D, 0}; pg8::gemm_phase(lds, g, S, E, tid);
        } break;
        case 17: case 21: {
            const int hf = (p == 21); const float* gnext = (l + 1 < DEPTH) ? norm_gains + (size_t)(l + 1) * 6 * D : nullptr;
            for (int m = gw; m < 8192; m += NGW) { const size_t mm = (size_t)hf * 8192 + m; resid_row(TMPH + (size_t)m * D, xres + mm * D, xres + mm * D, gains + 5 * D, gnext, XN + mm * D, lane); }
        } break;
        default: break;
        }
        __syncthreads();
    }
}

template <int P>
__global__ void __launch_bounds__(NTHR, 2) phase_kernel(Args args) {
    extern __shared__ __attribute__((aligned(16))) unsigned char lds_raw[];
    const int wave_s = wave_ticket((LAS unsigned char*)lds_raw, 131072 + 320);
    __syncthreads();
    run_phase<P>(args, args.layer, (LAS unsigned char*)lds_raw, wave_s);
}


constexpr int MISC_OFF = 131072 + 320;
__global__ void __launch_bounds__(NTHR, 2) mega_kernel(Args args) {
    extern __shared__ __attribute__((aligned(16))) unsigned char lds_raw[];
    LAS unsigned char* lds = (LAS unsigned char*)lds_raw;
    volatile LAS unsigned* MISC = (volatile LAS unsigned*)(lds + MISC_OFF);
    const int wave_s = wave_ticket(lds, MISC_OFF);
    const XcdBarrier bar = xcd_barrier_post((unsigned*)(args.ws + WS_CTL) + 4096, MISC + 8, wave_s == 0 && hw_lane() == 0);
#pragma unroll 1
    for (int l = 0; l < DEPTH; ++l) {
#define RUN(P) run_phase<P>(args, l, lds, wave_s); xcd_barrier(bar, wave_s);
        RUN(0) RUN(1) RUN(2) RUN(3) RUN(4) RUN(5) RUN(6) RUN(7) RUN(8) RUN(9) RUN(10) RUN(11) RUN(12) RUN(13) RUN(14) RUN(15) RUN(16) RUN(17) RUN(18) RUN(19) RUN(20) RUN(21)
#undef RUN
    }
}

extern "C" void kernel_launch(void* const* d_in, const int* in_sizes, int n_in, void* d_out, int out_size, void* d_ws, size_t ws_size, hipStream_t stream) {
    static int grid = 0;
    if (grid == 0) {
        if (n_in != 24 || out_size != T * D || ws_size < WS_END) { fprintf(stderr, "kernel_launch: unexpected shapes (n_in %d out %d ws %zu)\n", n_in, out_size, ws_size); grid = -1; return; }
        bool ok = true;
#define SETATTR(P) ok = ok && (hipFuncSetAttribute((const void*)phase_kernel<P>, hipFuncAttributeMaxDynamicSharedMemorySize, LDS_BYTES) == hipSuccess);
        SETATTR(0) SETATTR(1) SETATTR(2) SETATTR(3) SETATTR(4) SETATTR(5) SETATTR(6) SETATTR(7) SETATTR(8) SETATTR(9) SETATTR(10) SETATTR(11) SETATTR(12) SETATTR(13) SETATTR(14) SETATTR(15) SETATTR(16) SETATTR(17) SETATTR(18) SETATTR(19) SETATTR(20) SETATTR(21)
        ok = ok && (hipFuncSetAttribute((const void*)mega_kernel, hipFuncAttributeMaxDynamicSharedMemorySize, LDS_BYTES) == hipSuccess);
        if (!ok) { fprintf(stderr, "kernel_launch: hipFuncSetAttribute failed\n"); grid = -1; return; }
        int dev = 0, cus = 0;
        if (hipGetDevice(&dev) != hipSuccess || hipDeviceGetAttribute(&cus, hipDeviceAttributeMultiprocessorCount, dev) != hipSuccess) { grid = -1; return; }
        grid = cus;
    }
    if (grid < 0) return;
    Args a{};
    for (int i = 0; i < 24; ++i) a.in[i] = (const float*)d_in[i];
    a.out = (float*)d_out; a.ws = (unsigned char*)d_ws;
#if MK_ONE_LAUNCH
    if (hipMemsetAsync((char*)d_ws + WS_CTL, 0, 65536, stream) != hipSuccess) { fprintf(stderr, "kernel_launch: hipMemsetAsync failed\n"); return; }
    hipLaunchKernelGGL(mega_kernel, dim3(grid), dim3(NTHR), LDS_BYTES, stream, a);
#else
    for (int l = 0; l < DEPTH; ++l) {
        a.layer = l;
#define LAUNCH(P) hipLaunchKernelGGL(phase_kernel<P>, dim3(grid), dim3(NTHR), LDS_BYTES, stream, a);
        LAUNCH(0) LAUNCH(1) LAUNCH(2) LAUNCH(3) LAUNCH(4) LAUNCH(5) LAUNCH(6) LAUNCH(7) LAUNCH(8) LAUNCH(9) LAUNCH(10) LAUNCH(11) LAUNCH(12) LAUNCH(13) LAUNCH(14) LAUNCH(15) LAUNCH(16) LAUNCH(17) LAUNCH(18) LAUNCH(19) LAUNCH(20) LAUNCH(21)
    }
#endif
}
```

```cpp
#include <hip/hip_runtime.h>
#include <cstdio>
#include <cstdint>

#ifndef MK_ONE_LAUNCH
#define MK_ONE_LAUNCH 1
#endif

namespace pg8 {
#define PG8_LAS __attribute__((address_space(3)))
typedef unsigned short bf16_t;
typedef short bf16x8 __attribute__((ext_vector_type(8)));
typedef float f32x4 __attribute__((ext_vector_type(4)));
typedef float f32x2 __attribute__((ext_vector_type(2)));
typedef unsigned u32x4 __attribute__((ext_vector_type(4)));
constexpr int BM = 256, BK = 64, HALF = 128, HTB = HALF * BK * 2, STAGE_BYTES = 8 * HTB, NXCD = 8, WGM = 8;

__host__ __device__ __forceinline__ int lds_byte(int r, int c) { const int st = (r >> 4) * 2 + (c >> 5), rr = r & 15, cc = c & 31, ob = rr * 64 + cc * 2; return st * 1024 + (ob ^ (((ob >> 9) & 1) << 5)); }
__host__ __device__ __forceinline__ void stage_rc(int b, int& R, int& C) { const int st = b / 1024, sb = b % 1024, swz = sb ^ (((sb >> 9) & 1) << 5); R = (st >> 1) * 16 + swz / 64; C = (st & 1) * 32 + (swz % 64) / 2; }
__host__ __device__ __forceinline__ int perm32(int rho) { const int n = rho >> 4, i = rho & 15; return 8 * (i >> 2) + 4 * n + (i & 3); }

struct Unit { int pm, pn, z; };
struct Gemm { const bf16_t* A; const bf16_t* Bt; int lda, ldb, K, nz0; long sA0, sA1, sB0, sB1; };
__device__ __forceinline__ long zoff(int z, int nz0, long s0, long s1) { return (long)(z / nz0) * s1 + (long)(z % nz0) * s0; }

struct GenOrder {
    int nM, nN, nZ, nwg, G, c;
    __host__ __device__ void init(int nM_, int nN_, int nZ_, int G_, int c_) { nM = nM_; nN = nN_; nZ = nZ_; nwg = nM * nN * nZ; G = G_; c = c_; }
    __host__ __device__ bool next(int i, Unit& u) const {
        const long L = (long)i * G + c; if (L >= nwg) return false;
        int wgid = (int)L; { const int q = nwg / NXCD, r = nwg % NXCD, xcd = wgid % NXCD, off = wgid / NXCD; wgid = (xcd < r ? xcd * (q + 1) : r * (q + 1) + (xcd - r) * q) + off; }
        const int nMz = nM * nZ, nig = WGM * nN, gid = wgid / nig, fm = gid * WGM, gsz = (nMz - fm) < WGM ? (nMz - fm) : WGM;
        const int pmz = fm + ((wgid % nig) % gsz); u.pm = pmz % nM; u.z = pmz / nM; u.pn = (wgid % nig) / gsz; return true;
    }
};
struct RepeatOrder {
    GenOrder base; int nrep;
    __host__ __device__ void init(int nM_, int nN_, int nrep_, int G_, int c_) { base.init(nM_, nN_, 1, G_, c_); nrep = nrep_; }
    __host__ __device__ bool next(int i, Unit& u) const { if (!base.next(i / nrep, u)) return false; u.z = i % nrep; return true; }
};

__device__ __forceinline__ unsigned cvt_pk_bf16(float lo, float hi) { unsigned r; asm volatile("v_cvt_pk_bf16_f32 %0, %1, %2" : "=v"(r) : "v"(lo), "v"(hi)); return r; }
__device__ __forceinline__ float bf_lo(unsigned w) { return __uint_as_float(w << 16); }
__device__ __forceinline__ float bf_hi(unsigned w) { return __uint_as_float(w & 0xffff0000u); }

struct EpiBf16G {
    static constexpr bool PERM = true;
    bf16_t* O; int ldc; int nz0; long sC0, sC1; int split_cols; long split_stride; float scale;
    __device__ __forceinline__ void operator()(const f32x4 (&acc)[2][2][4][2], const Unit& u, int wr, int wc, int fr, int fq) const {
        const int row0 = u.pm * BM + wr * 64 + fr; int colt = u.pn * BM; bf16_t* base = O + zoff(u.z, nz0, sC0, sC1);
        if (split_cols) { const int t = colt / split_cols; base += (long)t * split_stride; colt -= t * split_cols; }
        const int col0 = colt + wc * 32 + 8 * fq;
#pragma unroll
        for (int ai = 0; ai < 2; ++ai)
#pragma unroll
            for (int m = 0; m < 4; ++m) { bf16_t* rowp = base + (size_t)(row0 + ai * HALF + m * 16) * ldc + col0;
#pragma unroll
                for (int bj = 0; bj < 2; ++bj) { const f32x4 v0 = acc[ai][bj][m][0] * scale, v1 = acc[ai][bj][m][1] * scale;
                    u32x4 w; w.x = cvt_pk_bf16(v0[0], v0[1]); w.y = cvt_pk_bf16(v0[2], v0[3]); w.z = cvt_pk_bf16(v1[0], v1[1]); w.w = cvt_pk_bf16(v1[2], v1[3]);
                    *(u32x4*)(rowp + bj * HALF) = w; } }
    }
};
struct EpiF32G {
    static constexpr bool PERM = false;
    float* C; int ldc; long sCz;
    __device__ __forceinline__ void operator()(const f32x4 (&acc)[2][2][4][2], const Unit& u, int wr, int wc, int fr, int fq) const {
        const int row0 = u.pm * BM + wr * 64 + fr, col0 = u.pn * BM + wc * 32 + 4 * fq; float* base = C + (long)u.z * sCz;
#pragma unroll
        for (int ai = 0; ai < 2; ++ai)
#pragma unroll
            for (int m = 0; m < 4; ++m) { float* rowp = base + (size_t)(row0 + ai * HALF + m * 16) * ldc + col0;
#pragma unroll
                for (int bj = 0; bj < 2; ++bj)
#pragma unroll
                    for (int n = 0; n < 2; ++n) *(f32x4*)(rowp + bj * HALF + n * 16) = acc[ai][bj][m][n]; }
    }
};
struct EpiGate {
    static constexpr bool PERM = true;
    const bf16_t* Bsrc; long sBz; bf16_t* merged; const float* gbias;
    __device__ __forceinline__ void operator()(const f32x4 (&acc)[2][2][4][2], const Unit& u, int wr, int wc, int fr, int fq) const {
        const int row0 = u.pm * BM + wr * 64 + fr, col0 = u.pn * BM + wc * 32 + 8 * fq; const bf16_t* bsrc = Bsrc + (long)u.z * sBz; const float* gb = gbias + u.z * 1024;
#pragma unroll
        for (int bj = 0; bj < 2; ++bj) { const f32x4 g0 = *(const f32x4*)(gb + col0 + bj * HALF), g1 = *(const f32x4*)(gb + col0 + bj * HALF + 4);
#pragma unroll
            for (int ai = 0; ai < 2; ++ai)
#pragma unroll
                for (int m = 0; m < 4; ++m) { const size_t off = (size_t)(row0 + ai * HALF + m * 16) * 1024 + col0 + bj * HALF;
                    const u32x4 bw = *(const u32x4*)(bsrc + off);
                    const f32x4 a0 = acc[ai][bj][m][0] + g0, a1 = acc[ai][bj][m][1] + g1; float r[8];
                    r[0] = bf_lo(bw.x) / (1.f + __expf(-a0[0])); r[1] = bf_hi(bw.x) / (1.f + __expf(-a0[1])); r[2] = bf_lo(bw.y) / (1.f + __expf(-a0[2])); r[3] = bf_hi(bw.y) / (1.f + __expf(-a0[3]));
                    r[4] = bf_lo(bw.z) / (1.f + __expf(-a1[0])); r[5] = bf_hi(bw.z) / (1.f + __expf(-a1[1])); r[6] = bf_lo(bw.w) / (1.f + __expf(-a1[2])); r[7] = bf_hi(bw.w) / (1.f + __expf(-a1[3]));
                    if (u.z != 0) { const u32x4 ow = *(const u32x4*)(merged + off);
                        r[0] += bf_lo(ow.x); r[1] += bf_hi(ow.x); r[2] += bf_lo(ow.y); r[3] += bf_hi(ow.y); r[4] += bf_lo(ow.z); r[5] += bf_hi(ow.z); r[6] += bf_lo(ow.w); r[7] += bf_hi(ow.w); }
                    u32x4 w; w.x = cvt_pk_bf16(r[0], r[1]); w.y = cvt_pk_bf16(r[2], r[3]); w.z = cvt_pk_bf16(r[4], r[5]); w.w = cvt_pk_bf16(r[6], r[7]);
                    *(u32x4*)(merged + off) = w; } }
    }
};

template <class Epi, class Sched, bool ALIGN_EPI = true>
__device__ __forceinline__ void gemm_phase(PG8_LAS unsigned char* lds, const Gemm g, const Sched& S, const Epi& E, const int tid) {
    const int wid = __builtin_amdgcn_readfirstlane(tid >> 6), lane = tid & 63, wr = wid >> 2, wc = wid & 3, fr = lane & 15, fq = lane >> 4;
    const int nt = g.K / BK;
    unsigned voffA[2], voffB[2];
#pragma unroll
    for (int i = 0; i < 2; ++i) { int R, C; stage_rc(tid * 16 + i * 8192, R, C); const int Rb = Epi::PERM ? ((R & ~31) + perm32(R & 31)) : R;
        voffA[i] = (unsigned)(R * g.lda + C) * 2u; voffB[i] = (unsigned)(Rb * g.ldb + C) * 2u; }
    const size_t kstep = (size_t)(BK * 2);
    const size_t hstepA = (size_t)HALF * g.lda * 2, hstepB = (size_t)HALF * g.ldb * 2;
    const unsigned ldsw = (unsigned)wid * 1024u;
    const int aoff = lds_byte(wr * 64 + fr, fq * 8), boff = lds_byte(wc * 32 + fr, fq * 8);
#define PG8_SA(b, h) (((b) * 2 + (h)) * HTB)
#define PG8_SB(b, h) ((4 + (b) * 2 + (h)) * HTB)
#define PG8_STAGE(bufoff, gbase, voff) do { _Pragma("unroll") for (int _i = 0; _i < 2; ++_i) \
        __builtin_amdgcn_global_load_lds((const unsigned*)((const char*)(gbase) + (voff)[_i]), (PG8_LAS unsigned*)(lds + (bufoff) + ldsw + _i * 8192), 16, 0, 0); } while (0)
#define PG8_LDA(dst, b, h) do { _Pragma("unroll") for (int m = 0; m < 4; ++m) _Pragma("unroll") for (int k = 0; k < 2; ++k) dst[m][k] = *(const PG8_LAS bf16x8*)(lds + PG8_SA(b, h) + aoff + m * 2048 + k * 1024); } while (0)
#define PG8_LDB(dst, b, h) do { _Pragma("unroll") for (int n = 0; n < 2; ++n) _Pragma("unroll") for (int k = 0; k < 2; ++k) dst[n][k] = *(const PG8_LAS bf16x8*)(lds + PG8_SB(b, h) + boff + n * 2048 + k * 1024); } while (0)
#define PG8_MMA(ai, bj, At, Bt) do { __builtin_amdgcn_s_setprio(1); _Pragma("unroll") for (int m = 0; m < 4; ++m) _Pragma("unroll") for (int n = 0; n < 2; ++n) _Pragma("unroll") for (int k = 0; k < 2; ++k) \
        acc[ai][bj][m][n] = __builtin_amdgcn_mfma_f32_16x16x32_bf16(Bt[n][k], At[m][k], acc[ai][bj][m][n], 0, 0, 0); __builtin_amdgcn_s_setprio(0); } while (0)
#define PG8_WAIT_V(n) asm volatile("s_waitcnt vmcnt(" #n ")" ::: "memory")
#define PG8_WAIT_L(n) asm volatile("s_waitcnt lgkmcnt(" #n ")" ::: "memory")
#define PG8_BAR __builtin_amdgcn_s_barrier()
#define PG8_SCHED __builtin_amdgcn_sched_barrier(0)
    Unit cur, nxt; int ui = 0;
    if (!S.next(0, cur)) return;
    f32x4 acc[2][2][4][2];
#pragma unroll
    for (int a = 0; a < 2; ++a)
#pragma unroll
        for (int b = 0; b < 2; ++b)
#pragma unroll
            for (int m = 0; m < 4; ++m)
#pragma unroll
                for (int n = 0; n < 2; ++n) acc[a][b][m][n] = (f32x4){0.f, 0.f, 0.f, 0.f};
    bf16x8 At[4][2], B0[2][2], B1[2][2];
    const char* cA = (const char*)(g.A + zoff(cur.z, g.nz0, g.sA0, g.sA1)) + (size_t)cur.pm * 2 * hstepA;
    const char* cB = (const char*)(g.Bt + zoff(cur.z, g.nz0, g.sB0, g.sB1)) + (size_t)cur.pn * 2 * hstepB;
    PG8_STAGE(PG8_SB(0, 0), cB, voffB); PG8_STAGE(PG8_SB(0, 1), cB + hstepB, voffB); PG8_STAGE(PG8_SA(0, 0), cA, voffA); PG8_STAGE(PG8_SA(0, 1), cA + hstepA, voffA);
    if (wr == 1) PG8_BAR;
    PG8_WAIT_V(2); PG8_BAR;
    PG8_STAGE(PG8_SB(1, 0), cB + kstep, voffB); PG8_STAGE(PG8_SA(1, 0), cA + kstep, voffA); PG8_STAGE(PG8_SB(1, 1), cB + hstepB + kstep, voffB);
    PG8_WAIT_V(6); PG8_BAR;
    for (;;) {
        const bool has_next = S.next(ui + 1, nxt);
        const char* nA = has_next ? (const char*)(g.A + zoff(nxt.z, g.nz0, g.sA0, g.sA1)) + (size_t)nxt.pm * 2 * hstepA : cA;
        const char* nB = has_next ? (const char*)(g.Bt + zoff(nxt.z, g.nz0, g.sB0, g.sB1)) + (size_t)nxt.pn * 2 * hstepB : cB;
        for (int t = 0; t < nt; t += 2) {
            const bool last = (t == nt - 2);
            const char* a1 = cA + (size_t)(t + 1) * kstep;
            const char* a2 = last ? nA : cA + (size_t)(t + 2) * kstep; const char* b2 = last ? nB : cB + (size_t)(t + 2) * kstep;
            const char* a3 = a2 + kstep; const char* b3 = b2 + kstep;
            PG8_LDB(B0, 0, 0); PG8_LDB(B1, 0, 1); PG8_SCHED; PG8_LDA(At, 0, 0); PG8_STAGE(PG8_SA(1, 1), a1 + hstepA, voffA);
            PG8_WAIT_V(8); PG8_WAIT_L(0); PG8_BAR; PG8_MMA(0, 0, At, B0); PG8_MMA(0, 1, At, B1); PG8_BAR; PG8_SCHED;
            PG8_LDA(At, 0, 1); PG8_STAGE(PG8_SB(0, 0), b2, voffB); PG8_STAGE(PG8_SB(0, 1), b2 + hstepB, voffB); PG8_STAGE(PG8_SA(0, 0), a2, voffA);
            PG8_WAIT_V(8); PG8_WAIT_L(0); PG8_BAR; PG8_MMA(1, 0, At, B0); PG8_MMA(1, 1, At, B1); PG8_BAR; PG8_SCHED;
            PG8_LDB(B0, 1, 0); PG8_LDB(B1, 1, 1); PG8_SCHED; PG8_LDA(At, 1, 0); PG8_STAGE(PG8_SA(0, 1), a2 + hstepA, voffA);
            PG8_WAIT_V(8); PG8_WAIT_L(0); PG8_BAR; PG8_MMA(0, 0, At, B0); PG8_MMA(0, 1, At, B1); PG8_BAR; PG8_SCHED;
            PG8_LDA(At, 1, 1); PG8_STAGE(PG8_SB(1, 0), b3, voffB); PG8_STAGE(PG8_SB(1, 1), b3 + hstepB, voffB); PG8_STAGE(PG8_SA(1, 0), a3, voffA);
            PG8_WAIT_V(8); PG8_WAIT_L(0); PG8_BAR; PG8_MMA(1, 0, At, B0); PG8_MMA(1, 1, At, B1); PG8_BAR; PG8_SCHED;
        }
        if constexpr (ALIGN_EPI) { if (wr == 0) PG8_BAR; }
        E(acc, cur, wr, wc, fr, fq);
        if (!has_next) break;
#pragma unroll
        for (int a = 0; a < 2; ++a)
#pragma unroll
            for (int b = 0; b < 2; ++b)
#pragma unroll
                for (int m = 0; m < 4; ++m)
#pragma unroll
                    for (int n = 0; n < 2; ++n) acc[a][b][m][n] = (f32x4){0.f, 0.f, 0.f, 0.f};
        cur = nxt; cA = nA; cB = nB; ++ui;
        if constexpr (ALIGN_EPI) { if (wr == 1) PG8_BAR; }
    }
    PG8_WAIT_V(0);
    if constexpr (!ALIGN_EPI) { if (wr == 0) PG8_BAR; }
    PG8_BAR;
#undef PG8_SA
#undef PG8_SB
#undef PG8_STAGE
#undef PG8_LDA
#undef PG8_LDB
#undef PG8_MMA
#undef PG8_WAIT_V
#undef PG8_WAIT_L
#undef PG8_BAR
#undef PG8_SCHED
}
}

constexpr int NWAVES = 8, NTHR = NWAVES * 64;
constexpr int NB = 8, SEQ = 2048, D = 1024, T = NB * SEQ, NMEM = 256, PROJW = 7680, HYW = 512, DFF = 2816, DEPTH = 2;
constexpr int TM = NB * NMEM;
constexpr float EPS = 1e-6f;
constexpr size_t MiB = 1u << 20;
constexpr size_t WS_CTL = 0, CTL_ZERO_BYTES = 1 * MiB;
constexpr size_t WS_WB = 1 * MiB;
constexpr size_t WS_FILT = 21 * MiB;
constexpr size_t WS_XN = 37 * MiB;
constexpr size_t WS_BIG = 69 * MiB;
constexpr size_t WS_END = 256 * MiB;

typedef unsigned short bf16;
typedef unsigned v4u __attribute__((ext_vector_type(4)));
typedef unsigned v2u __attribute__((ext_vector_type(2)));
typedef float f32x4 __attribute__((ext_vector_type(4)));
#define LAS __attribute__((address_space(3)))
#define LDS_WAIT() asm volatile("s_waitcnt lgkmcnt(0)" ::: "memory")
__device__ __forceinline__ unsigned f2bf(float f) { unsigned u = __builtin_bit_cast(unsigned, f); return (u + 0x7fffu + ((u >> 16) & 1u)) >> 16; }
__device__ __forceinline__ unsigned pk2(float lo, float hi) { return f2bf(lo) | (f2bf(hi) << 16); }
__device__ __forceinline__ float bf2f(unsigned short h) { return __uint_as_float(((unsigned)h) << 16); }
__device__ __forceinline__ float bflo(unsigned w) { return __uint_as_float(w << 16); }
__device__ __forceinline__ float bfhi(unsigned w) { return __uint_as_float(w & 0xffff0000u); }
__device__ __forceinline__ int hw_lane() { int l; asm volatile("v_mbcnt_lo_u32_b32 %0, -1, 0\n\tv_mbcnt_hi_u32_b32 %0, -1, %0" : "=v"(l)); return l; }
__device__ __forceinline__ float wave_sum(float v) {
#pragma unroll
    for (int o = 1; o < 64; o <<= 1) v += __shfl_xor(v, o);
    return v;
}
__device__ __forceinline__ float wave_max(float v) {
#pragma unroll
    for (int o = 1; o < 64; o <<= 1) v = fmaxf(v, __shfl_xor(v, o));
    return v;
}

__device__ __forceinline__ void transpose_item(const float* W, int K, int N, bf16* WT, int row_off, LAS float* scr, int item, int lane) {
    const int nblk = N / 32, kb = item / nblk, nb = item % nblk, k0 = 64 * kb, n0 = 32 * nb;
#pragma unroll 8
    for (int i = 0; i < 32; ++i) { const int kk = 2 * i + (lane >> 5); scr[kk * 33 + (lane & 31)] = W[(size_t)(k0 + kk) * N + n0 + (lane & 31)]; }
    LDS_WAIT(); asm volatile("" ::: "memory");
    const int c = lane & 7;
#pragma unroll
    for (int j = 0; j < 4; ++j) { const int n = (lane >> 3) + 8 * j; const LAS float* s = scr + (8 * c) * 33 + n;
        v4u o; o.x = pk2(s[0 * 33], s[1 * 33]); o.y = pk2(s[2 * 33], s[3 * 33]); o.z = pk2(s[4 * 33], s[5 * 33]); o.w = pk2(s[6 * 33], s[7 * 33]);
        *(v4u*)(WT + (size_t)(row_off + n0 + n) * K + k0 + 8 * c) = o; }
    LDS_WAIT(); asm volatile("" ::: "memory");
}
__device__ __forceinline__ void convert_weight(const float* W, int K, int N, bf16* WT, LAS unsigned char* lds, int gw, int NGW, int wave, int lane) {
    LAS float* scr = (LAS float*)(lds + wave * 16384);
    const int nitems = (K / 64) * (N / 32);
    for (int it = gw; it < nitems; it += NGW) transpose_item(W, K, N, WT, 0, scr, it, lane);
}
__device__ __forceinline__ void rms_row_to_bf16(const float* xrow, const float* g, bf16* orow, int lane) {
    const f32x4* xr = (const f32x4*)xrow + lane; const f32x4* gr = (const f32x4*)g + lane;
    f32x4 v[4]; float s = 0.f;
#pragma unroll
    for (int j = 0; j < 4; ++j) { v[j] = xr[64 * j]; s += (v[j].x * v[j].x + v[j].y * v[j].y) + (v[j].z * v[j].z + v[j].w * v[j].w); }
    const float rstd = 1.0f / sqrtf(wave_sum(s) * (1.f / D) + EPS);
    unsigned long long* o8 = (unsigned long long*)orow + lane;
#pragma unroll
    for (int j = 0; j < 4; ++j) { const f32x4 gg = gr[64 * j]; o8[64 * j] = (unsigned long long)pk2(v[j].x * rstd * gg.x, v[j].y * rstd * gg.y) | ((unsigned long long)pk2(v[j].z * rstd * gg.z, v[j].w * rstd * gg.w) << 32); }
}
__device__ __forceinline__ void resid_row(const float* trow, const float* xold, float* xout, const float* ga, const float* gb, bf16* xnrow, int lane) {
    const f32x4* tr = (const f32x4*)trow + lane; const f32x4* xo = (const f32x4*)xold + lane; const f32x4* gar = (const f32x4*)ga + lane;
    f32x4 v[4]; float s = 0.f;
#pragma unroll
    for (int j = 0; j < 4; ++j) { v[j] = tr[64 * j]; s += (v[j].x * v[j].x + v[j].y * v[j].y) + (v[j].z * v[j].z + v[j].w * v[j].w); }
    const float rstd = 1.0f / sqrtf(wave_sum(s) * (1.f / D) + EPS);
    float s2 = 0.f;
#pragma unroll
    for (int j = 0; j < 4; ++j) { const f32x4 gg = gar[64 * j]; const f32x4 xv = xo[64 * j]; v[j] = xv + v[j] * rstd * gg; s2 += (v[j].x * v[j].x + v[j].y * v[j].y) + (v[j].z * v[j].z + v[j].w * v[j].w); }
    f32x4* xw = (f32x4*)xout + lane;
#pragma unroll
    for (int j = 0; j < 4; ++j) xw[64 * j] = v[j];
    if (gb) {
        const float rstd2 = 1.0f / sqrtf(wave_sum(s2) * (1.f / D) + EPS); const f32x4* gbr = (const f32x4*)gb + lane;
        unsigned long long* o8 = (unsigned long long*)xnrow + lane;
#pragma unroll
        for (int j = 0; j < 4; ++j) { const f32x4 gg = gbr[64 * j]; o8[64 * j] = (unsigned long long)pk2(v[j].x * rstd2 * gg.x, v[j].y * rstd2 * gg.y) | ((unsigned long long)pk2(v[j].z * rstd2 * gg.z, v[j].w * rstd2 * gg.w) << 32); }
    }
}

__device__ __forceinline__ void hyena_filter_unit(int unit, const float* w1, const float* b1, const float* w2, const float* b2, const float* w3, const float* freq, bf16* RT, LAS unsigned char* lds, int tid) {
    LAS float* zL = (LAS float*)lds;
    LAS float* h1L = zL + 32 * 33;
    LAS float* h2L = h1L + 32 * 64;
    LAS float* oL = h2L + 32 * 64;
    const int pt = unit >> 2, cg = unit & 3, p0 = pt * 32;
    for (int i = tid; i < 32 * 33; i += NTHR) { const int p = i / 33, f = i % 33; const int pos = p0 + p; float val;
        if (f == 0) val = (float)pos / (float)(SEQ - 1);
        else { const int band = (f - 1) & 15; const float fb = 1e-4f + (float)band * ((15.0f - 1e-4f) / 15.0f); const float w = (6.283185307179586f * (float)pos) / (float)SEQ; const float a = fb * w;
            val = (f <= 16) ? cosf(a) : -sinf(a); }
        zL[p * 33 + f] = val; }
    __syncthreads();
    for (int i = tid; i < 32 * 64; i += NTHR) { const int p = i >> 6, k = i & 63; float s = b1[k];
        for (int f = 0; f < 33; ++f) s += zL[p * 33 + f] * w1[f * 64 + k];
        h1L[p * 64 + k] = sinf(freq[k] * s); }
    __syncthreads();
    for (int i = tid; i < 32 * 64; i += NTHR) { const int p = i >> 6, k = i & 63; float s = b2[k];
        for (int f = 0; f < 64; ++f) s += h1L[p * 64 + f] * w2[f * 64 + k];
        h2L[k * 32 + p] = sinf(freq[64 + k] * s); }
    __syncthreads();
    {
        const int col = cg * 512 + tid; const int c = col & 511;
        float sacc[32];
#pragma unroll
        for (int p = 0; p < 32; ++p) sacc[p] = 0.f;
#pragma unroll 1
        for (int k = 0; k < 64; ++k) { const float wk = w3[(size_t)k * 2048 + col];
#pragma unroll
            for (int p = 0; p < 32; p += 4) { const f32x4 hv = *(const LAS f32x4*)(h2L + k * 32 + p);
                sacc[p] += hv.x * wk; sacc[p + 1] += hv.y * wk; sacc[p + 2] += hv.z * wk; sacc[p + 3] += hv.w * wk; } }
        const float d0 = 4.605170185988091f / 1.5f, d1 = 4.605170185988091f / 0.3f;
        const float delta = d0 + (float)c * ((d1 - d0) / 511.0f);
#pragma unroll
        for (int p = 0; p < 32; ++p) { const float tt = (float)(p0 + p) / (float)(SEQ - 1); oL[tid * 33 + p] = sacc[p] * expf(-tt * delta); }
    }
    __syncthreads();
    for (int i = tid; i < 512 * 32; i += NTHR) { const int jc = i >> 5, p = i & 31; const int j = cg * 512 + jc, dir = j >> 10, o = (j >> 9) & 1, c = j & 511; const int pos = p0 + p;
        const float val = oL[jc * 33 + p]; bf16* dst = RT + ((size_t)(c * 2 + o)) * 4096;
        if (dir == 0) dst[2048 - pos] = (bf16)f2bf(val); else if (pos >= 1) dst[2048 + pos] = (bf16)f2bf(val); }
    __syncthreads();
}

__device__ __forceinline__ void hyena_unit(int c, bf16* HYT, const float* FILT, const float* short_w, const float* hbias, LAS unsigned char* lds, int tid) {
    LAS float* vS = (LAS float*)lds;
    LAS float* gS = vS + 2048 * 8;
    const bf16* rv = HYT + (size_t)c * T; const bf16* r1 = HYT + (size_t)(512 + c) * T; bf16* r2 = HYT + (size_t)(1024 + c) * T;
    const float wv0 = short_w[c], wv1 = short_w[1536 + c], wv2 = short_w[3072 + c];
    const float wa0 = short_w[512 + c], wa1 = short_w[1536 + 512 + c], wa2 = short_w[3072 + 512 + c];
    const float wb0 = short_w[1024 + c], wb1 = short_w[1536 + 1024 + c], wb2 = short_w[3072 + 1024 + c];
    const float bias0 = hbias[c], bias1 = hbias[512 + c];
    float x1c[4][8], x2c[4][8], acc[4][8];
#pragma unroll
    for (int k = 0; k < 4; ++k)
#pragma unroll
        for (int b = 0; b < 8; ++b) { const int t = tid + 512 * k; const size_t m = (size_t)b * SEQ + t; const bool lo = t > 0, hi = t < SEQ - 1;
            const float vm = lo ? bf2f(rv[m - 1]) : 0.f, v0 = bf2f(rv[m]), vp = hi ? bf2f(rv[m + 1]) : 0.f;
            const float am = lo ? bf2f(r1[m - 1]) : 0.f, a0 = bf2f(r1[m]), ap = hi ? bf2f(r1[m + 1]) : 0.f;
            const float bm = lo ? bf2f(r2[m - 1]) : 0.f, b0 = bf2f(r2[m]), bp = hi ? bf2f(r2[m + 1]) : 0.f;
            vS[t * 8 + b] = wv0 * vm + wv1 * v0 + wv2 * vp; x1c[k][b] = wa0 * am + wa1 * a0 + wa2 * ap; x2c[k][b] = wb0 * bm + wb1 * b0 + wb2 * bp; }
#pragma unroll 1
    for (int o = 0; o < 2; ++o) {
        const float* gsrc = FILT + ((size_t)(c * 2 + o)) * 4096;
        for (int i = tid; i < 4096; i += NTHR) gS[i] = (i == 0) ? 0.f : gsrc[i];
        __syncthreads();
#pragma unroll
        for (int k = 0; k < 4; ++k)
#pragma unroll
            for (int b = 0; b < 8; ++b) acc[k][b] = 0.f;
        const LAS float* gp = gS + tid + 2048;
#pragma unroll 2
        for (int s = 0; s < SEQ; ++s) {
            const f32x4 va = *(const LAS f32x4*)(vS + s * 8), vb = *(const LAS f32x4*)(vS + s * 8 + 4);
#pragma unroll
            for (int k = 0; k < 4; ++k) { const float gk = gp[512 * k - s];
                acc[k][0] += gk * va.x; acc[k][1] += gk * va.y; acc[k][2] += gk * va.z; acc[k][3] += gk * va.w;
                acc[k][4] += gk * vb.x; acc[k][5] += gk * vb.y; acc[k][6] += gk * vb.z; acc[k][7] += gk * vb.w; }
        }
        const float bias = o == 0 ? bias0 : bias1;
#pragma unroll
        for (int k = 0; k < 4; ++k)
#pragma unroll
            for (int b = 0; b < 8; ++b) { const int t = tid + 512 * k; const float own = vS[t * 8 + b]; const float r = acc[k][b] + bias * own; acc[k][b] = (o == 0 ? x1c[k][b] : x2c[k][b]) * r; }
        __syncthreads();
        if (o == 0) {
#pragma unroll
            for (int k = 0; k < 4; ++k)
#pragma unroll
                for (int b = 0; b < 8; ++b) vS[(tid + 512 * k) * 8 + b] = acc[k][b];
        } else {
#pragma unroll
            for (int k = 0; k < 4; ++k)
#pragma unroll
                for (int b = 0; b < 8; ++b) r2[(size_t)b * SEQ + tid + 512 * k] = (bf16)f2bf(acc[k][b]);
        }
    }
    __syncthreads();
}

__device__ __forceinline__ void na_item(int item, bf16* NAQ, const bf16* NAK, const bf16* NAV, const float* rpb, int lane) {
    const int h = item & 7, m = item >> 3, b = m >> 11, t = m & 2047, r = t >> 6, cc = t & 63;
    int rs = r - 4; rs = rs < 0 ? 0 : (rs > 24 ? 24 : rs);
    int cs = cc - 8; cs = cs < 0 ? 0 : (cs > 48 ? 48 : cs);
    const v4u* qp = (const v4u*)(NAQ + (size_t)m * 512 + h * 64);
    v4u q[8];
#pragma unroll
    for (int i = 0; i < 8; ++i) q[i] = qp[i];
    float sc[2];
#pragma unroll
    for (int kq = 0; kq < 2; ++kq) { const int kk = lane + 64 * kq, i = kk >> 4, j = kk & 15; const int mk = b * SEQ + (rs + i) * 64 + cs + j;
        const v4u* kp = (const v4u*)(NAK + (size_t)mk * 512 + h * 64); float d = 0.f;
#pragma unroll
        for (int e = 0; e < 8; ++e) { const v4u kv = kp[e]; const v4u qv = q[e];
            d += bflo(qv.x) * bflo(kv.x) + bfhi(qv.x) * bfhi(kv.x) + bflo(qv.y) * bflo(kv.y) + bfhi(qv.y) * bfhi(kv.y) + bflo(qv.z) * bflo(kv.z) + bfhi(qv.z) * bfhi(kv.z) + bflo(qv.w) * bflo(kv.w) + bfhi(qv.w) * bfhi(kv.w); }
        const int dr = (rs + i) - r + 7, dc = (cs + j) - cc + 15;
        sc[kq] = d * 0.125f + rpb[(h * 15 + dr) * 31 + dc]; }
    const float mx = wave_max(fmaxf(sc[0], sc[1]));
    const float e0 = __expf(sc[0] - mx), e1 = __expf(sc[1] - mx);
    const float inv = 1.0f / wave_sum(e0 + e1);
    const float p0 = e0 * inv, p1 = e1 * inv;
    float o = 0.f;
#pragma unroll 4
    for (int kk = 0; kk < 128; ++kk) { const float p = __shfl(kk < 64 ? p0 : p1, kk & 63); const int i = kk >> 4, j = kk & 15; const int mk = b * SEQ + (rs + i) * 64 + cs + j;
        o += p * bf2f(NAV[(size_t)mk * 512 + h * 64 + lane]); }
    NAQ[(size_t)m * 512 + h * 64 + lane] = (bf16)f2bf(o);
}


constexpr int HY_CS = 8256;
constexpr int HY_ZS = 8 * HY_CS;
constexpr int HY_ROWB = 6272;
constexpr int HY_PADB = 7;
typedef float f32x16 __attribute__((ext_vector_type(16)));
typedef short bf16x8v __attribute__((ext_vector_type(8)));
__device__ __forceinline__ int hy_zbyte(int b, int pos) { const int pp = pos + 32 * HY_PADB; return HY_ZS + b * HY_ROWB + (pp >> 5) * 80 + (pp & 31) * 2; }
__device__ __forceinline__ void conv8(const v4u raw, float prev, float next, float w0, float w1, float w2, float (&o)[8]) {
    float x[10]; x[0] = prev; x[1] = bflo(raw.x); x[2] = bfhi(raw.x); x[3] = bflo(raw.y); x[4] = bfhi(raw.y); x[5] = bflo(raw.z); x[6] = bfhi(raw.z); x[7] = bflo(raw.w); x[8] = bfhi(raw.w); x[9] = next;
#pragma unroll
    for (int j = 0; j < 8; ++j) o[j] = w0 * x[j] + w1 * x[j + 1] + w2 * x[j + 2];
}
__device__ __forceinline__ v4u conv8_row(const bf16* row, size_t m, int t0, float w0, float w1, float w2) {
    const v4u raw = *(const v4u*)(row + m); const float prev = t0 > 0 ? bf2f(row[m - 1]) : 0.f, next = (t0 + 8 < SEQ) ? bf2f(row[m + 8]) : 0.f;
    float o[8]; conv8(raw, prev, next, w0, w1, w2, o);
    v4u r; r.x = pk2(o[0], o[1]); r.y = pk2(o[2], o[3]); r.z = pk2(o[4], o[5]); r.w = pk2(o[6], o[7]); return r;
}
__device__ __forceinline__ void hy_build_copies(const bf16* rt, LAS unsigned char* lds, int tid) {
    for (int ch = tid; ch < 513; ch += NTHR) {
        v4u lo = (v4u){0u, 0u, 0u, 0u}, hi = (v4u){0u, 0u, 0u, 0u};
        if (ch >= 1) lo = *(const v4u*)(rt + (ch - 1) * 8);
        if (ch < 512) hi = *(const v4u*)(rt + ch * 8);
        const unsigned wd[8] = {lo.x, lo.y, lo.z, lo.w, hi.x, hi.y, hi.z, hi.w};
#pragma unroll
        for (int q = 0; q < 8; ++q) { const int s = 8 - q; v4u o;
            if ((s & 1) == 0) { const int d0 = s >> 1; o.x = wd[d0]; o.y = wd[d0 + 1]; o.z = wd[d0 + 2]; o.w = wd[d0 + 3]; }
            else { const int d0 = (s - 1) >> 1; o.x = (wd[d0] >> 16) | (wd[d0 + 1] << 16); o.y = (wd[d0 + 1] >> 16) | (wd[d0 + 2] << 16); o.z = (wd[d0 + 2] >> 16) | (wd[d0 + 3] << 16); o.w = (wd[d0 + 3] >> 16) | (wd[d0 + 4] << 16); }
            *(LAS v4u*)(lds + q * HY_CS + ch * 16) = o; }
    }
}
__device__ __forceinline__ void hyena_unit_mfma(int c, bf16* HYT, const bf16* RT, const float* short_w, const float* hbias, LAS unsigned char* lds, int tid, int w, int lane) {
    const bf16* rv = HYT + (size_t)c * T; const bf16* r1 = HYT + (size_t)(512 + c) * T; bf16* r2 = HYT + (size_t)(1024 + c) * T;
    const float wv0 = short_w[c], wv1 = short_w[1536 + c], wv2 = short_w[3072 + c];
    const float wa0 = short_w[512 + c], wa1 = short_w[1536 + 512 + c], wa2 = short_w[3072 + 512 + c];
    const float wb0 = short_w[1024 + c], wb1 = short_w[1536 + 1024 + c], wb2 = short_w[3072 + 1024 + c];
    v4u x1p[4], x2p[4];
#pragma unroll
    for (int k = 0; k < 4; ++k) { const int ci = tid + NTHR * k, b = ci >> 8, t0 = (ci & 255) * 8; const size_t m = (size_t)b * SEQ + t0;
        *(LAS v4u*)(lds + hy_zbyte(b, t0)) = conv8_row(rv, m, t0, wv0, wv1, wv2);
        x1p[k] = conv8_row(r1, m, t0, wa0, wa1, wa2); x2p[k] = conv8_row(r2, m, t0, wb0, wb1, wb2); }
    hy_build_copies(RT + ((size_t)(c * 2 + 0)) * 4096, lds, tid);
    __syncthreads();
    const int r = lane & 31, h = lane >> 5, q = r & 7, a3 = r >> 3;
#pragma unroll 1
    for (int o = 0; o < 2; ++o) {
        f32x16 acc0, acc1;
#pragma unroll
        for (int i = 0; i < 16; ++i) { acc0[i] = 0.f; acc1[i] = 0.f; }
        int pa = q * HY_CS + 8160 + 16 * (h - a3) - 512 * w;
        int pb0 = HY_ZS + (r >> 3) * HY_ROWB + ((r & 7) + 70) * 80 + 16 * h;
        int pb1 = pb0 + 4 * HY_ROWB;
#pragma unroll 1
        for (int p = 0; p < 71; ++p) {
            const bf16x8v ao = *(const LAS bf16x8v*)(lds + pa), ae = *(const LAS bf16x8v*)(lds + pa - 32);
            const bf16x8v b0o = *(const LAS bf16x8v*)(lds + pb0 + 32), b0e = *(const LAS bf16x8v*)(lds + pb0);
            const bf16x8v b1o = *(const LAS bf16x8v*)(lds + pb1 + 32), b1e = *(const LAS bf16x8v*)(lds + pb1);
            acc0 = __builtin_amdgcn_mfma_f32_32x32x16_bf16(ao, b0o, acc0, 0, 0, 0); acc1 = __builtin_amdgcn_mfma_f32_32x32x16_bf16(ao, b1o, acc1, 0, 0, 0);
            acc0 = __builtin_amdgcn_mfma_f32_32x32x16_bf16(ae, b0e, acc0, 0, 0, 0); acc1 = __builtin_amdgcn_mfma_f32_32x32x16_bf16(ae, b1e, acc1, 0, 0, 0);
            pa -= 64; pb0 -= 80; pb1 -= 80;
        }
        __syncthreads();
        const float bias = hbias[o * 512 + c];
#pragma unroll
        for (int bh = 0; bh < 2; ++bh) { const int b = 4 * bh + (r >> 3), i = 8 * w + (r & 7);
#pragma unroll
            for (int rg = 0; rg < 4; ++rg) { const int zb = hy_zbyte(b, 32 * i + 8 * rg + 4 * h); const v2u old = *(const LAS v2u*)(lds + zb);
                const float y0 = (bh ? acc1[4 * rg + 0] : acc0[4 * rg + 0]) + bias * bflo(old.x), y1 = (bh ? acc1[4 * rg + 1] : acc0[4 * rg + 1]) + bias * bfhi(old.x);
                const float y2 = (bh ? acc1[4 * rg + 2] : acc0[4 * rg + 2]) + bias * bflo(old.y), y3 = (bh ? acc1[4 * rg + 3] : acc0[4 * rg + 3]) + bias * bfhi(old.y);
                v2u nw; nw.x = pk2(y0, y1); nw.y = pk2(y2, y3); *(LAS v2u*)(lds + zb) = nw; } }
        __syncthreads();
        if (o == 0) {
#pragma unroll
            for (int k = 0; k < 4; ++k) { const int ci = tid + NTHR * k, b = ci >> 8, t0 = (ci & 255) * 8; const int zb = hy_zbyte(b, t0); const v4u yv = *(const LAS v4u*)(lds + zb); const v4u xv = x1p[k];
                v4u z; z.x = pk2(bflo(yv.x) * bflo(xv.x), bfhi(yv.x) * bfhi(xv.x)); z.y = pk2(bflo(yv.y) * bflo(xv.y), bfhi(yv.y) * bfhi(xv.y)); z.z = pk2(bflo(yv.z) * bflo(xv.z), bfhi(yv.z) * bfhi(xv.z)); z.w = pk2(bflo(yv.w) * bflo(xv.w), bfhi(yv.w) * bfhi(xv.w));
                *(LAS v4u*)(lds + zb) = z; }
            hy_build_copies(RT + ((size_t)(c * 2 + 1)) * 4096, lds, tid);
        } else {
#pragma unroll
            for (int k = 0; k < 4; ++k) { const int ci = tid + NTHR * k, b = ci >> 8, t0 = (ci & 255) * 8; const int zb = hy_zbyte(b, t0); const v4u yv = *(const LAS v4u*)(lds + zb); const v4u xv = x2p[k];
                v4u z; z.x = pk2(bflo(yv.x) * bflo(xv.x), bfhi(yv.x) * bfhi(xv.x)); z.y = pk2(bflo(yv.y) * bflo(xv.y), bfhi(yv.y) * bfhi(xv.y)); z.z = pk2(bflo(yv.z) * bflo(xv.z), bfhi(yv.z) * bfhi(xv.z)); z.w = pk2(bflo(yv.w) * bflo(xv.w), bfhi(yv.w) * bfhi(xv.w));
                *(v4u*)(r2 + (size_t)b * SEQ + t0) = z; }
        }
        __syncthreads();
    }
}

constexpr int NA_VOFF = 65536, NA_RPB = 131072;
typedef short v4i16_t __attribute__((ext_vector_type(4)));
__device__ __forceinline__ void na_unit(int unit, bf16* NAQ, const bf16* NAK, const bf16* NAV, const float* rpb, LAS unsigned char* lds, int tid, int wave, int lane) {
    const int r = unit & 31, h = (unit >> 5) & 7, b = unit >> 8;
    int rs = r - 4; rs = rs < 0 ? 0 : (rs > 24 ? 24 : rs);
    const size_t m0 = (size_t)b * SEQ + rs * 64;
    {
        v4u kreg[8], vreg[8];
#pragma unroll
        for (int j = 0; j < 8; ++j) { const int idx = tid + NTHR * j, kidx = idx >> 3, ch = idx & 7; const size_t go = (m0 + kidx) * 512 + h * 64 + ch * 8;
            kreg[j] = *(const v4u*)(NAK + go); vreg[j] = *(const v4u*)(NAV + go); }
#pragma unroll
        for (int j = 0; j < 8; ++j) { const int idx = tid + NTHR * j, kidx = idx >> 3, ch = idx & 7;
            *(LAS v4u*)(lds + kidx * 128 + ((ch ^ (kidx & 7)) * 16)) = kreg[j];
            *(LAS v4u*)(lds + NA_VOFF + kidx * 128 + (((ch >> 1) ^ ((kidx >> 1) & 3)) * 32) + (ch & 1) * 16) = vreg[j]; }
        if (tid < 465) ((LAS float*)(lds + NA_RPB))[tid] = rpb[h * 465 + tid];
    }
    __syncthreads();
    if (wave < 4) {
        const int qi = lane & 15, g = lane >> 4, c0 = 16 * wave; int kc0 = c0 - 8; kc0 = kc0 < 0 ? 0 : (kc0 > 32 ? 32 : kc0);
        const size_t mq = (size_t)b * SEQ + r * 64 + c0 + qi;
        const bf16x8v qf0 = *(const bf16x8v*)(NAQ + mq * 512 + h * 64 + 8 * g), qf1 = *(const bf16x8v*)(NAQ + mq * 512 + h * 64 + 32 + 8 * g);
        f32x4 sacc[8][2];
#pragma unroll
        for (int kr = 0; kr < 8; ++kr)
#pragma unroll
            for (int hb = 0; hb < 2; ++hb) { const int key = kr * 64 + kc0 + 16 * hb + qi;
                const bf16x8v a0 = *(const LAS bf16x8v*)(lds + key * 128 + ((g ^ (key & 7)) * 16)), a1 = *(const LAS bf16x8v*)(lds + key * 128 + (((g + 4) ^ (key & 7)) * 16));
                f32x4 s = (f32x4){0.f, 0.f, 0.f, 0.f};
                s = __builtin_amdgcn_mfma_f32_16x16x32_bf16(a0, qf0, s, 0, 0, 0); s = __builtin_amdgcn_mfma_f32_16x16x32_bf16(a1, qf1, s, 0, 0, 0); sacc[kr][hb] = s; }
        const int c = c0 + qi; int cs = c - 8; cs = cs < 0 ? 0 : (cs > 48 ? 48 : cs);
        const LAS float* rp = (const LAS float*)(lds + NA_RPB);
        float mx = -3.0e38f;
#pragma unroll
        for (int kr = 0; kr < 8; ++kr)
#pragma unroll
            for (int hb = 0; hb < 2; ++hb)
#pragma unroll
                for (int e = 0; e < 4; ++e) { const int kc = kc0 + 16 * hb + 4 * g + e; const bool ok = (kc >= cs) && (kc < cs + 16); const int dr = rs + kr - r + 7, dc = kc - c + 15;
                    const float bv = rp[ok ? (dr * 31 + dc) : 0]; const float s = ok ? (sacc[kr][hb][e] * 0.125f + bv) : -1.0e30f; sacc[kr][hb][e] = s; mx = fmaxf(mx, s); }
        mx = fmaxf(mx, __shfl_xor(mx, 16)); mx = fmaxf(mx, __shfl_xor(mx, 32));
        float sum = 0.f;
#pragma unroll
        for (int kr = 0; kr < 8; ++kr)
#pragma unroll
            for (int hb = 0; hb < 2; ++hb)
#pragma unroll
                for (int e = 0; e < 4; ++e) { const float p = __expf(sacc[kr][hb][e] - mx); sacc[kr][hb][e] = p; sum += p; }
        sum += __shfl_xor(sum, 16); sum += __shfl_xor(sum, 32);
        const float inv = 1.0f / sum;
        f32x4 oacc[4];
#pragma unroll
        for (int mb = 0; mb < 4; ++mb) oacc[mb] = (f32x4){0.f, 0.f, 0.f, 0.f};
        const int qrow = qi >> 2, pp = qi & 3;
#pragma unroll
        for (int s = 0; s < 8; ++s) {
            v4u pw; pw.x = pk2(sacc[s][0][0] * inv, sacc[s][0][1] * inv); pw.y = pk2(sacc[s][0][2] * inv, sacc[s][0][3] * inv); pw.z = pk2(sacc[s][1][0] * inv, sacc[s][1][1] * inv); pw.w = pk2(sacc[s][1][2] * inv, sacc[s][1][3] * inv);
            const bf16x8v pf = __builtin_bit_cast(bf16x8v, pw);
            const int key0 = s * 64 + kc0 + 4 * g + qrow, key1 = key0 + 16;
#pragma unroll
            for (int mb = 0; mb < 4; ++mb) {
                const v4i16_t t0 = __builtin_amdgcn_ds_read_tr16_b64_v4i16((LAS v4i16_t*)(lds + NA_VOFF + key0 * 128 + ((mb ^ ((key0 >> 1) & 3)) * 32) + 8 * pp));
                const v4i16_t t1 = __builtin_amdgcn_ds_read_tr16_b64_v4i16((LAS v4i16_t*)(lds + NA_VOFF + key1 * 128 + ((mb ^ ((key1 >> 1) & 3)) * 32) + 8 * pp));
                bf16x8v vf; vf[0] = t0[0]; vf[1] = t0[1]; vf[2] = t0[2]; vf[3] = t0[3]; vf[4] = t1[0]; vf[5] = t1[1]; vf[6] = t1[2]; vf[7] = t1[3];
                oacc[mb] = __builtin_amdgcn_mfma_f32_16x16x32_bf16(vf, pf, oacc[mb], 0, 0, 0); }
        }
#pragma unroll
        for (int mb = 0; mb < 4; ++mb) { v2u ow; ow.x = pk2(oacc[mb][0], oacc[mb][1]); ow.y = pk2(oacc[mb][2], oacc[mb][3]);
            *(v2u*)(NAQ + mq * 512 + h * 64 + 16 * mb + 4 * g) = ow; }
    }
    __syncthreads();
}

__device__ __forceinline__ void sc_item(int item, bf16* SCB, const bf16* SCC, const bf16* SCX, const float* w) {
    const int m = item >> 6, ch = (item & 63) * 8, t = m & 2047;
    const size_t off = (size_t)m * 512 + ch;
    const v4u bw = *(const v4u*)(SCB + off);
    float accv[8];
#pragma unroll
    for (int e = 0; e < 8; ++e) accv[e] = 0.f;
#pragma unroll
    for (int k = 0; k < 3; ++k) { const int tt = t + k - 1; if (tt < 0 || tt >= SEQ) continue;
        const size_t o2 = (size_t)(m + k - 1) * 512 + ch; const v4u cw = *(const v4u*)(SCC + o2), xw = *(const v4u*)(SCX + o2); const float* wk = w + k * 512 + ch;
        accv[0] += wk[0] * bflo(cw.x) * bflo(xw.x); accv[1] += wk[1] * bfhi(cw.x) * bfhi(xw.x); accv[2] += wk[2] * bflo(cw.y) * bflo(xw.y); accv[3] += wk[3] * bfhi(cw.y) * bfhi(xw.y);
        accv[4] += wk[4] * bflo(cw.z) * bflo(xw.z); accv[5] += wk[5] * bfhi(cw.z) * bfhi(xw.z); accv[6] += wk[6] * bflo(cw.w) * bflo(xw.w); accv[7] += wk[7] * bfhi(cw.w) * bfhi(xw.w); }
    v4u o; o.x = pk2(bflo(bw.x) * accv[0], bfhi(bw.x) * accv[1]); o.y = pk2(bflo(bw.y) * accv[2], bfhi(bw.y) * accv[3]); o.z = pk2(bflo(bw.z) * accv[4], bfhi(bw.z) * accv[5]); o.w = pk2(bflo(bw.w) * accv[6], bfhi(bw.w) * accv[7]);
    *(v4u*)(SCB + off) = o;
}

__device__ __forceinline__ void ya_transpose_item(int item, const bf16* YAT, bf16* YA, LAS unsigned char* ldsw, int lane) {
    LAS unsigned short* tl = (LAS unsigned short*)ldsw;
    const int cb = item & 7, tb = item >> 3, c0 = cb * 64, t0 = tb * 64;
#pragma unroll 8
    for (int i = 0; i < 64; ++i) tl[i * 66 + lane] = YAT[(size_t)(c0 + i) * T + t0 + lane];
    LDS_WAIT(); asm volatile("" ::: "memory");
#pragma unroll 8
    for (int i = 0; i < 64; ++i) YA[(size_t)(t0 + i) * 512 + c0 + lane] = tl[lane * 66 + i];
    LDS_WAIT(); asm volatile("" ::: "memory");
}

__device__ __forceinline__ void softmax_row(const float* srow, bf16* prow, int lane) {
    const f32x4 v = ((const f32x4*)srow)[lane];
    const float mx = wave_max(fmaxf(fmaxf(v.x, v.y), fmaxf(v.z, v.w)));
    const float e0 = __expf(v.x - mx), e1 = __expf(v.y - mx), e2 = __expf(v.z - mx), e3 = __expf(v.w - mx);
    const float inv = 1.0f / wave_sum((e0 + e1) + (e2 + e3));
    ((unsigned long long*)prow)[lane] = (unsigned long long)pk2(e0 * inv, e1 * inv) | ((unsigned long long)pk2(e2 * inv, e3 * inv) << 32);
}

__device__ __forceinline__ float gelu_tanh(float x) { const float u = 0.7978845608028654f * (x + 0.044715f * x * x * x); return 0.5f * x * (1.0f + tanhf(u)); }
__device__ __forceinline__ void glu_item(int item, const bf16* U, bf16* ACT, const float* wc) {
    const int row = item / 352, ch = (item % 352) * 8, t = row & 2047;
    float g[8], v[8];
#pragma unroll
    for (int e = 0; e < 8; ++e) { g[e] = 0.f; v[e] = 0.f; }
#pragma unroll
    for (int k = 0; k < 3; ++k) { const int tt = t + k - 1; if (tt < 0 || tt >= SEQ) continue;
        const bf16* ur = U + (size_t)(row + k - 1) * (2 * DFF); const v4u gw = *(const v4u*)(ur + ch), vw = *(const v4u*)(ur + DFF + ch); const float* wg = wc + k * (2 * DFF) + ch; const float* wv = wg + DFF;
        g[0] += wg[0] * bflo(gw.x); g[1] += wg[1] * bfhi(gw.x); g[2] += wg[2] * bflo(gw.y); g[3] += wg[3] * bfhi(gw.y); g[4] += wg[4] * bflo(gw.z); g[5] += wg[5] * bfhi(gw.z); g[6] += wg[6] * bflo(gw.w); g[7] += wg[7] * bfhi(gw.w);
        v[0] += wv[0] * bflo(vw.x); v[1] += wv[1] * bfhi(vw.x); v[2] += wv[2] * bflo(vw.y); v[3] += wv[3] * bfhi(vw.y); v[4] += wv[4] * bflo(vw.z); v[5] += wv[5] * bfhi(vw.z); v[6] += wv[6] * bflo(vw.w); v[7] += wv[7] * bfhi(vw.w); }
    v4u o; o.x = pk2(gelu_tanh(g[0]) * v[0], gelu_tanh(g[1]) * v[1]); o.y = pk2(gelu_tanh(g[2]) * v[2], gelu_tanh(g[3]) * v[3]); o.z = pk2(gelu_tanh(g[4]) * v[4], gelu_tanh(g[5]) * v[5]); o.w = pk2(gelu_tanh(g[6]) * v[6], gelu_tanh(g[7]) * v[7]);
    *(v4u*)(ACT + (size_t)row * DFF + ch) = o;
}


#define XB_TMO      128
#define XB_XCNT(j)  (256  + 64 * (j))
#define XB_XSUB(j)  (1280 + 64 * (j))
#define XB_XGEN(j)  (2304 + 64 * (j))
#define XB_TOP      3328
#define XB_TOPGEN   3392
#define XCD_BAR_WORDS 3456
#define XB_SPIN_CAP (1u << 18)
__device__ __forceinline__ unsigned xb_ld(unsigned* p)              { return __hip_atomic_load(p, __ATOMIC_RELAXED, __HIP_MEMORY_SCOPE_AGENT); }
__device__ __forceinline__ unsigned xb_add(unsigned* p, unsigned v) { return __hip_atomic_fetch_add(p, v, __ATOMIC_RELAXED, __HIP_MEMORY_SCOPE_AGENT); }
__device__ __forceinline__ unsigned xb_xcc_id() { return (unsigned)__builtin_amdgcn_s_getreg((3 << 11) | 20) & 0xFu; }
#define XB_SPIN(cond, bar) do { unsigned _sp = 0; while (cond) { __builtin_amdgcn_s_sleep(1); \
    if ((++_sp & 255u) == 0u) { if (xb_ld(&(bar)[XB_TMO])) break; if (_sp > XB_SPIN_CAP) { atomicAdd(&(bar)[XB_TMO], 1u); break; } } } } while (0)
struct XcdBarrier { unsigned* bar; unsigned x; volatile LAS unsigned* st; };
__device__ __forceinline__ XcdBarrier xcd_barrier_post(unsigned* bar, volatile LAS unsigned* st, bool leader) {
    XcdBarrier b; b.bar = bar; b.x = xb_xcc_id(); b.st = st;
    if (leader) (void)xb_add(&bar[XB_XCNT(b.x)], 1u);
    return b;
}
__device__ __forceinline__ void xcd_barrier_complete(unsigned* bar, unsigned x, unsigned& nloc, unsigned& nx) {
    const unsigned G = gridDim.x * gridDim.y * gridDim.z;
    unsigned sum, cnt, mine, sp = 0u;
    for (;;) {
        sum = 0u; cnt = 0u; mine = 0u;
#pragma unroll
        for (unsigned j = 0; j < 16; ++j) { const unsigned c = xb_ld(&bar[XB_XCNT(j)]); sum += c; cnt += (c > 0u) ? 1u : 0u; mine = (j == x) ? c : mine; }
        if (sum == G) break;
        __builtin_amdgcn_s_sleep(1);
        if ((++sp & 255u) == 0u) { if (xb_ld(&bar[XB_TMO])) break; if (sp > XB_SPIN_CAP) { atomicAdd(&bar[XB_TMO], 1u); break; } }
    }
    nloc = mine > 0u ? mine : 1u; nx = cnt > 0u ? cnt : 1u;
}
__device__ __forceinline__ void xcd_barrier(const XcdBarrier& b, const int wave_s) {
    asm volatile("s_waitcnt vmcnt(0)" ::: "memory");
    __syncthreads();
    if (wave_s == 0 && hw_lane() == 0) {
        unsigned* bar = b.bar;
        __builtin_amdgcn_s_waitcnt(0);
        unsigned nloc = b.st[0], nx = b.st[1];
        if (nloc == 0u) { xcd_barrier_complete(bar, b.x, nloc, nx); b.st[0] = nloc; b.st[1] = nx; }
        const unsigned old = xb_add(&bar[XB_XSUB(b.x)], 1u);
        const unsigned gen = old / nloc;
        if (old + 1u == (gen + 1u) * nloc) {
            __builtin_amdgcn_fence(__ATOMIC_RELEASE, "agent");
            asm volatile("s_waitcnt vmcnt(0)" ::: "memory");
            const unsigned og = xb_add(&bar[XB_TOP], 1u);
            const unsigned tg = og / nx;
            if (og + 1u == (tg + 1u) * nx) xb_add(&bar[XB_TOPGEN], 1u);
            else XB_SPIN(xb_ld(&bar[XB_TOPGEN]) == tg, bar);
            __builtin_amdgcn_fence(__ATOMIC_ACQUIRE, "agent");
            xb_add(&bar[XB_XGEN(b.x)], 1u);
            asm volatile("s_waitcnt vmcnt(0)" ::: "memory");
        } else {
            XB_SPIN(xb_ld(&bar[XB_XGEN(b.x)]) == gen, bar);
            __builtin_amdgcn_fence(__ATOMIC_ACQUIRE, "agent");
            asm volatile("s_waitcnt vmcnt(0)" ::: "memory");
        }
    }
    __syncthreads();
}

constexpr int LDS_BYTES = 147456;
constexpr int PH_PER_LAYER = 22;
struct Args { const float* in[24]; float* out; unsigned char* ws; int layer, pad; };

__device__ __forceinline__ int wave_ticket(LAS unsigned char* lds, int off) {
    volatile LAS unsigned* w = (volatile LAS unsigned*)(lds + off);
    if (threadIdx.x < 32) w[threadIdx.x] = 0u;
    const int wv = __builtin_amdgcn_readfirstlane((int)(threadIdx.x >> 6));
    __syncthreads();
    return wv;
}
template <int P>
__device__ __forceinline__ void run_phase(const Args& args, const int l, LAS unsigned char* lds, const int wave_s) {
    int lane_ = hw_lane(); asm volatile("" : "+v"(lane_));
    int wave_ = wave_s; asm volatile("" : "+s"(wave_));
    const int lane = lane_, wave = wave_, tid = wave * 64 + lane;
    const int G = gridDim.x, bx = blockIdx.x;
    const int vcu = (G % 8 == 0) ? (bx % 8) * (G / 8) + bx / 8 : bx;
    const int gw = vcu * NWAVES + wave, NGW = G * NWAVES;
    const int gt = vcu * NTHR + tid, NGT = G * NTHR;
    unsigned char* ws = args.ws;
    const float* x_in = args.in[0]; const float* mem = args.in[1]; const float* norm_gains = args.in[2]; const float* mem_norm = args.in[3];
    const float* w_in = args.in[4]; const float* gate_bias = args.in[5]; const float* hy_short_w = args.in[6]; const float* hy_w1 = args.in[7]; const float* hy_b1 = args.in[8];
    const float* hy_w2 = args.in[9]; const float* hy_b2 = args.in[10]; const float* hy_w3 = args.in[11]; const float* hy_freq = args.in[12]; const float* hy_bias = args.in[13];
    const float* na_rpb = args.in[14]; const float* sc_conv_w = args.in[15]; const float* w_branch = args.in[16]; const float* w_out = args.in[17];
    const float* xa_wq = args.in[18]; const float* xa_wkv = args.in[19]; const float* xa_wo = args.in[20]; const float* ffn_up = args.in[21]; const float* ffn_conv = args.in[22]; const float* ffn_down = args.in[23];
    float* xres = args.out;
    bf16* WB = (bf16*)(ws + WS_WB); bf16* FILT = (bf16*)(ws + WS_FILT); bf16* XN = (bf16*)(ws + WS_XN); unsigned char* BIG = ws + WS_BIG;
    bf16* HYT = (bf16*)BIG; bf16* NAQ = (bf16*)(BIG + 48 * MiB); bf16* NAK = (bf16*)(BIG + 64 * MiB); bf16* NAV = (bf16*)(BIG + 80 * MiB);
    bf16* SCB = (bf16*)(BIG + 96 * MiB); bf16* SCC = (bf16*)(BIG + 112 * MiB); bf16* SCX = (bf16*)(BIG + 128 * MiB); bf16* MERGED = (bf16*)(BIG + 144 * MiB);
    bf16* YA = (bf16*)BIG; bf16* B0 = (bf16*)(BIG + 16 * MiB); float* TMP_M = (float*)BIG;
    bf16* w_in_t = WB; bf16* wb_t = WB + (size_t)PROJW * D; bf16* w_out_t = wb_t + (size_t)3 * D * HYW;
    bf16* MEMN = (bf16*)(ws + WS_FILT); bf16* KMEM = MEMN + (size_t)TM * D; bf16* VT = KMEM + (size_t)TM * D;
    bf16* QO = (bf16*)BIG; float* SBUF = (float*)(BIG + 32 * MiB); bf16* PBUF = (bf16*)(BIG + 96 * MiB); float* TMP_X = (float*)(BIG + 32 * MiB);
    bf16* wq_t = WB; bf16* wkv_t = WB + (size_t)D * D; bf16* wo_t = wkv_t + (size_t)2 * D * D;
    bf16* UBUF = (bf16*)BIG; bf16* ACT = (bf16*)(BIG + 88 * MiB); float* TMPH = (float*)(BIG + 132 * MiB);
    bf16* up_t = WB; bf16* down_t = WB + (size_t)2 * DFF * D;

    {
        constexpr int p = P;
        const float* gains = norm_gains + (size_t)l * 6 * D;
        switch (p) {
        case 0: {
            convert_weight(w_in + (size_t)l * D * PROJW, D, PROJW, w_in_t, lds, gw, NGW, wave, lane);
            for (int i = 0; i < 3; ++i) convert_weight(w_branch + ((size_t)l * 3 + i) * HYW * D, HYW, D, wb_t + (size_t)i * D * HYW, lds, gw, NGW, wave, lane);
            convert_weight(w_out + (size_t)l * D * D, D, D, w_out_t, lds, gw, NGW, wave, lane);
            __syncthreads();
            for (int u = vcu; u < 256; u += G) hyena_filter_unit(u, hy_w1 + (size_t)l * 33 * 64, hy_b1 + l * 64, hy_w2 + (size_t)l * 64 * 64, hy_b2 + l * 64, hy_w3 + (size_t)l * 64 * 2048, hy_freq + l * 128, FILT, lds, tid);
            if (l == 0) for (int m = gw; m < T; m += NGW) rms_row_to_bf16(x_in + (size_t)m * D, gains, XN + (size_t)m * D, lane);
        } break;
        case 1: {
            { pg8::Gemm g{w_in_t, XN, D, D, D, 1, 0, 0, 0, 0}; pg8::GenOrder S; S.init(6, 64, 1, G, bx);
              pg8::EpiBf16G E{HYT, T, 1, 0, 0, 0, 0, 1.f}; pg8::gemm_phase(lds, g, S, E, tid); }
            { pg8::Gemm g{XN, w_in_t + (size_t)1536 * D, D, D, D, 1, 0, 0, 0, 0}; pg8::GenOrder S; S.init(64, 12, 1, G, bx);
              pg8::EpiBf16G E{NAQ, 512, 1, 0, 0, 512, (long)T * 512, 1.f}; pg8::gemm_phase(lds, g, S, E, tid); }
        } break;
        case 2: {
            for (int i = tid; i < 8 * HY_ROWB / 16; i += NTHR) *(LAS v4u*)(lds + HY_ZS + i * 16) = (v4u){0u, 0u, 0u, 0u};
            __syncthreads();
            for (int c = vcu; c < 512; c += G) hyena_unit_mfma(c, HYT, FILT, hy_short_w + (size_t)l * 3 * 1536, hy_bias + (size_t)l * 2 * 512, lds, tid, wave, lane);
            for (int u = vcu; u < NB * 8 * 32; u += G) na_unit(u, NAQ, NAK, NAV, na_rpb + (size_t)l * 8 * 15 * 31, lds, tid, wave, lane);
            for (int it = gt; it < T * 64; it += NGT) sc_item(it, SCB, SCC, SCX, sc_conv_w + (size_t)l * 3 * 512);
        } break;
        case 3: {
            for (int it = gw; it < 8 * (T / 64); it += NGW) ya_transpose_item(it, HYT + (size_t)1024 * T, YA, lds + wave * 16384, lane);
        } break;
        case 4: {
            pg8::Gemm g{YA, wb_t, 512, 512, 512, 1, 0, (long)(24 * MiB), 0, (long)D * HYW}; pg8::GenOrder S; S.init(64, 4, 3, G, bx);
            pg8::EpiBf16G E{B0, D, 1, 0, (long)(24 * MiB), 0, 0, 1.f}; pg8::gemm_phase(lds, g, S, E, tid);
        } break;
        case 5: {
            pg8::Gemm g{XN, w_in_t + (size_t)4608 * D, D, D, D, 1, 0, 0, 0, (long)D * D}; pg8::RepeatOrder S; S.init(64, 4, 3, G, bx);
            pg8::EpiGate E{B0, (long)(24 * MiB), MERGED, gate_bias + (size_t)l * 3 * D}; pg8::gemm_phase(lds, g, S, E, tid);
        } break;
        case 6: {
            pg8::Gemm g{MERGED, w_out_t, D, D, D, 1, 0, 0, 0, 0}; pg8::GenOrder S; S.init(64, 4, 1, G, bx);
            pg8::EpiF32G E{TMP_M, D, 0}; pg8::gemm_phase(lds, g, S, E, tid);
        } break;
        case 7: {
            for (int m = gw; m < T; m += NGW) resid_row(TMP_M + (size_t)m * D, (l == 0 ? x_in : xres) + (size_t)m * D, xres + (size_t)m * D, gains + D, gains + 2 * D, XN + (size_t)m * D, lane);
            convert_weight(xa_wq + (size_t)l * D * D, D, D, wq_t, lds, gw, NGW, wave, lane);
            convert_weight(xa_wkv + (size_t)l * D * 2 * D, D, 2 * D, wkv_t, lds, gw, NGW, wave, lane);
            convert_weight(xa_wo + (size_t)l * D * D, D, D, wo_t, lds, gw, NGW, wave, lane);
            for (int m = gw; m < TM; m += NGW) rms_row_to_bf16(mem + (size_t)m * D, mem_norm + (size_t)l * D, MEMN + (size_t)m * D, lane);
        } break;
        case 8: {
            { pg8::Gemm g{XN, wq_t, D, D, D, 1, 0, 0, 0, 0}; pg8::GenOrder S; S.init(64, 4, 1, G, bx);
              pg8::EpiBf16G E{QO, D, 1, 0, 0, 0, 0, 0.0625f}; pg8::gemm_phase(lds, g, S, E, tid); }
            { pg8::Gemm g{MEMN, wkv_t, D, D, D, 1, 0, 0, 0, 0}; pg8::GenOrder S; S.init(8, 4, 1, G, bx);
              pg8::EpiBf16G E{KMEM, D, 1, 0, 0, 0, 0, 1.f}; pg8::gemm_phase(lds, g, S, E, tid); }
            { pg8::Gemm g{wkv_t + (size_t)D * D, MEMN, D, D, D, 1, 0, 0, 0, 0}; pg8::GenOrder S; S.init(4, 8, 1, G, bx);
              pg8::EpiBf16G E{VT, TM, 1, 0, 0, 0, 0, 1.f}; pg8::gemm_phase(lds, g, S, E, tid); }
        } break;
        case 9: {
            pg8::Gemm g{QO, KMEM, D, D, 256, 4, 256, (long)SEQ * D, 256, (long)NMEM * D}; pg8::GenOrder S; S.init(8, 1, 32, G, bx);
            pg8::EpiF32G E{SBUF, 256, (long)SEQ * 256}; pg8::gemm_phase(lds, g, S, E, tid);
        } break;
        case 10: {
            for (int r = gw; r < 32 * SEQ; r += NGW) softmax_row(SBUF + (size_t)r * 256, PBUF + (size_t)r * 256, lane);
        } break;
        case 11: {
            pg8::Gemm g{PBUF, VT, 256, TM, 256, 4, (long)SEQ * 256, (long)4 * SEQ * 256, (long)256 * TM, 256}; pg8::GenOrder S; S.init(8, 1, 32, G, bx);
            pg8::EpiBf16G E{QO, D, 4, 256, (long)SEQ * D, 0, 0, 1.f}; pg8::gemm_phase(lds, g, S, E, tid);
        } break;
        case 12: {
            pg8::Gemm g{QO, wo_t, D, D, D, 1, 0, 0, 0, 0}; pg8::GenOrder S; S.init(64, 4, 1, G, bx);
            pg8::EpiF32G E{TMP_X, D, 0}; pg8::gemm_phase(lds, g, S, E, tid);
        } break;
        case 13: {
            for (int m = gw; m < T; m += NGW) resid_row(TMP_X + (size_t)m * D, xres + (size_t)m * D, xres + (size_t)m * D, gains + 3 * D, gains + 4 * D, XN + (size_t)m * D, lane);
            convert_weight(ffn_up + (size_t)l * D * 2 * DFF, D, 2 * DFF, up_t, lds, gw, NGW, wave, lane);
            convert_weight(ffn_down + (size_t)l * DFF * D, DFF, D, down_t, lds, gw, NGW, wave, lane);
        } break;
        case 14: case 18: {
            const int hf = (p == 18);
            pg8::Gemm g{XN + (size_t)hf * 8192 * D, up_t, D, D, D, 1, 0, 0, 0, 0}; pg8::GenOrder S; S.init(32, 22, 1, G, bx);
            pg8::EpiBf16G E{UBUF, 2 * DFF, 1, 0, 0, 0, 0, 1.f}; pg8::gemm_phase(lds, g, S, E, tid);
        } break;
        case 15: case 19: {
            for (int it = gt; it < 8192 * 352; it += NGT) glu_item(it, UBUF, ACT, ffn_conv + (size_t)l * 3 * 2 * DFF);
        } break;
        case 16: case 20: {
            pg8::Gemm g{ACT, down_t, DFF, DFF, DFF, 1, 0, 0, 0, 0}; pg8::GenOrder S; S.init(32, 4, 1, G, bx);
            pg8::EpiF32G E{TMPH, D, 0}; pg8::gemm_phase(lds, g, S, E, tid);
        } break;
        case 17: case 21: {
            const int hf = (p == 21); const float* gnext = (l + 1 < DEPTH) ? norm_gains + (size_t)(l + 1) * 6 * D : nullptr;
            for (int m = gw; m < 8192; m += NGW) { const size_t mm = (size_t)hf * 8192 + m; resid_row(TMPH + (size_t)m * D, xres + mm * D, xres + mm * D, gains + 5 * D, gnext, XN + mm * D, lane); }
        } break;
        default: break;
        }
        __syncthreads();
    }
}

template <int P>
__global__ void __launch_bounds__(NTHR, 2) phase_kernel(Args args) {
    extern __shared__ __attribute__((aligned(16))) unsigned char lds_raw[];
    const int wave_s = wave_ticket((LAS unsigned char*)lds_raw, 131072 + 4096);
    __syncthreads();
    run_phase<P>(args, args.layer, (LAS unsigned char*)lds_raw, wave_s);
}


constexpr int MISC_OFF = 131072 + 4096;
__global__ void __launch_bounds__(NTHR, 2) mega_kernel(Args args) {
    extern __shared__ __attribute__((aligned(16))) unsigned char lds_raw[];
    LAS unsigned char* lds = (LAS unsigned char*)lds_raw;
    volatile LAS unsigned* MISC = (volatile LAS unsigned*)(lds + MISC_OFF);
    const int wave_s = wave_ticket(lds, MISC_OFF);
    const XcdBarrier bar = xcd_barrier_post((unsigned*)(args.ws + WS_CTL) + 4096, MISC + 8, wave_s == 0 && hw_lane() == 0);
#pragma unroll 1
    for (int l = 0; l < DEPTH; ++l) {
#define RUN(P) run_phase<P>(args, l, lds, wave_s); xcd_barrier(bar, wave_s);
        RUN(0) RUN(1) RUN(2) RUN(3) RUN(4) RUN(5) RUN(6) RUN(7) RUN(8) RUN(9) RUN(10) RUN(11) RUN(12) RUN(13) RUN(14) RUN(15) RUN(16) RUN(17) RUN(18) RUN(19) RUN(20) RUN(21)
#undef RUN
    }
}

extern "C" void kernel_launch(void* const* d_in, const int* in_sizes, int n_in, void* d_out, int out_size, void* d_ws, size_t ws_size, hipStream_t stream) {
    static int grid = 0;
    if (grid == 0) {
        if (n_in != 24 || out_size != T * D || ws_size < WS_END) { fprintf(stderr, "kernel_launch: unexpected shapes (n_in %d out %d ws %zu)\n", n_in, out_size, ws_size); grid = -1; return; }
        bool ok = true;
#define SETATTR(P) ok = ok && (hipFuncSetAttribute((const void*)phase_kernel<P>, hipFuncAttributeMaxDynamicSharedMemorySize, LDS_BYTES) == hipSuccess);
        SETATTR(0) SETATTR(1) SETATTR(2) SETATTR(3) SETATTR(4) SETATTR(5) SETATTR(6) SETATTR(7) SETATTR(8) SETATTR(9) SETATTR(10) SETATTR(11) SETATTR(12) SETATTR(13) SETATTR(14) SETATTR(15) SETATTR(16) SETATTR(17) SETATTR(18) SETATTR(19) SETATTR(20) SETATTR(21)
        ok = ok && (hipFuncSetAttribute((const void*)mega_kernel, hipFuncAttributeMaxDynamicSharedMemorySize, LDS_BYTES) == hipSuccess);
        if (!ok) { fprintf(stderr, "kernel_launch: hipFuncSetAttribute failed\n"); grid = -1; return; }
        int dev = 0, cus = 0;
        if (hipGetDevice(&dev) != hipSuccess || hipDeviceGetAttribute(&cus, hipDeviceAttributeMultiprocessorCount, dev) != hipSuccess) { grid = -1; return; }
        grid = cus;
    }
    if (grid < 0) return;
    Args a{};
    for (int i = 0; i < 24; ++i) a.in[i] = (const float*)d_in[i];
    a.out = (float*)d_out; a.ws = (unsigned char*)d_ws;
#if MK_ONE_LAUNCH
    if (hipMemsetAsync((char*)d_ws + WS_CTL, 0, 65536, stream) != hipSuccess) { fprintf(stderr, "kernel_launch: hipMemsetAsync failed\n"); return; }
    hipLaunchKernelGGL(mega_kernel, dim3(grid), dim3(NTHR), LDS_BYTES, stream, a);
#else
    for (int l = 0; l < DEPTH; ++l) {
        a.layer = l;
#define LAUNCH(P) hipLaunchKernelGGL(phase_kernel<P>, dim3(grid), dim3(NTHR), LDS_BYTES, stream, a);
        LAUNCH(0) LAUNCH(1) LAUNCH(2) LAUNCH(3) LAUNCH(4) LAUNCH(5) LAUNCH(6) LAUNCH(7) LAUNCH(8) LAUNCH(9) LAUNCH(10) LAUNCH(11) LAUNCH(12) LAUNCH(13) LAUNCH(14) LAUNCH(15) LAUNCH(16) LAUNCH(17) LAUNCH(18) LAUNCH(19) LAUNCH(20) LAUNCH(21)
    }
#endif
}
```
